# Optimizing an MI355X kernel written in HIP

```python
import jax, jax.numpy as jnp
from jax import lax
import numpy as np

D_MODEL = 1024
BATCH = 32
SEQ = 256
DEPTH = 2
DEC_BATCH = 8
DEC_SEQ = 2048
PAST_LEN = 512

GRID_W = 64
RET_HEADS = 4
RET_DK = 128
RET_DV = 256
RET_QK_W = RET_HEADS * RET_DK
RET_V_W = RET_HEADS * RET_DV
RET_CHUNK = 128
NA_HEADS = 8
NA_DH = 64
NA_W = NA_HEADS * NA_DH
NA_WIN_H = 8
NA_WIN_W = 16
Q_BLOCK = 128
D_FF = -(-8 * D_MODEL // (3 * 256)) * 256
ROPE_BASE = 10000.0
EPS = 1e-6
IN_WIDTHS = (RET_QK_W, RET_QK_W, RET_V_W, RET_V_W, NA_W, NA_W, NA_W)
IN_WIDTH = sum(IN_WIDTHS)

kernel_name = 'hybrid_retention_natten_diffusion_step'


def rmsnorm(x, g):
    xf = x.astype(jnp.float32)
    y = xf * lax.rsqrt(jnp.mean(xf * xf, axis=-1, keepdims=True) + EPS)
    return (y * g.astype(jnp.float32)).astype(x.dtype)


def adaln(cvec, w_ada, b_ada):
    return jnp.split(jax.nn.silu(cvec) @ w_ada + b_ada, 6, axis=-1)


def modulate(h, shift, scale):
    return h * (1 + scale[:, None, :]) + shift[:, None, :]


def project_in(hm, w_in):
    b, l = hm.shape[:2]
    points = [int(p) for p in np.cumsum(IN_WIDTHS)[:-1]]
    rq, rk, rv, rg, nq, nk, nv = jnp.split(hm @ w_in, points, axis=-1)
    return (rq.reshape(b, l, RET_HEADS, RET_DK), rk.reshape(b, l, RET_HEADS, RET_DK),
            rv.reshape(b, l, RET_HEADS, RET_DV), rg,
            nq.reshape(b, l, NA_HEADS, NA_DH), nk.reshape(b, l, NA_HEADS, NA_DH),
            nv.reshape(b, l, NA_HEADS, NA_DH))


def rope_2d(x):
    l = x.shape[1]
    t = jnp.arange(l)
    row = (t // GRID_W).astype(jnp.float32)
    col = (t % GRID_W).astype(jnp.float32)
    n_freq = x.shape[-1] // 4
    inv = ROPE_BASE ** (-jnp.arange(n_freq, dtype=jnp.float32) / n_freq)
    ang = jnp.concatenate([row[:, None] * inv, col[:, None] * inv], axis=-1)
    cos = jnp.cos(ang)[None, :, None, :]
    sin = jnp.sin(ang)[None, :, None, :]
    x1, x2 = jnp.split(x.astype(jnp.float32), 2, axis=-1)
    return jnp.concatenate([x1 * cos - x2 * sin, x1 * sin + x2 * cos], axis=-1).astype(x.dtype)


def retention_chunked(q, k, v, log_gamma, s0):
    b, l, h, dk = q.shape
    dv = v.shape[-1]
    n = l // RET_CHUNK
    pos = jnp.arange(RET_CHUNK, dtype=jnp.float32)
    rel = pos[:, None] - pos[None, :]
    decay_in = jnp.where(rel >= 0, jnp.exp(log_gamma[:, None, None] * jnp.maximum(rel, 0.0)), 0.0)
    xi = jnp.exp(log_gamma[:, None] * (pos + 1.0)).T[None, :, :, None]
    zeta = jnp.exp(log_gamma[:, None] * (RET_CHUNK - 1.0 - pos)).T[None, :, :, None]
    g_chunk = jnp.exp(log_gamma * RET_CHUNK)[None, :, None, None]

    def chunks(a):
        return jnp.moveaxis(a.reshape(b, n, RET_CHUNK, *a.shape[2:]), 1, 0)

    def step(s, inp):
        qc, kc, vc = inp
        scores = jnp.einsum('bnhd,bmhd->bhnm', qc, kc) * decay_in
        inner = jnp.einsum('bhnm,bmhe->bnhe', scores, vc)
        cross = jnp.einsum('bnhd,bhde->bnhe', qc, s) * xi
        s_new = g_chunk * s + jnp.einsum('bmhd,bmhe->bhde', kc * zeta, vc)
        return s_new, inner + cross

    s_fin, out = lax.scan(step, s0, (chunks(q), chunks(k), chunks(v)))
    return jnp.moveaxis(out, 0, 1).reshape(b, l, h, dv), s_fin


def retention_bidir(q, k, v, log_g, s0_f, s0_b):
    y_f, s_f = retention_chunked(q, k, v, log_g[0], s0_f)
    fl = lambda a: jnp.flip(a, axis=1)
    y_b, s_b = retention_chunked(fl(q), fl(k), fl(v), log_g[1], s0_b)
    return y_f + fl(y_b), s_f, s_b


def retention_output(y, gate, gn_gain):
    b, l = y.shape[:2]
    mu = jnp.mean(y, axis=-1, keepdims=True)
    var = jnp.mean(jnp.square(y - mu), axis=-1, keepdims=True)
    yn = ((y - mu) * lax.rsqrt(var + EPS)).reshape(b, l, RET_V_W) * gn_gain.astype(jnp.float32)
    return (jax.nn.silu(gate.astype(jnp.float32)) * yn).astype(gate.dtype)


def context_attention(q, k, v):
    b, lc, h, d = q.shape
    nb = lc // Q_BLOCK
    qb = jnp.moveaxis(q.reshape(b, nb, Q_BLOCK, h, d), 1, 0)

    def blk(qi):
        s = jnp.einsum('bqhd,bkhd->bhqk', qi, k).astype(jnp.float32)
        p = jax.nn.softmax(s, axis=-1).astype(v.dtype)
        return jnp.einsum('bhqk,bkhd->bqhd', p, v)

    o = lax.map(blk, qb)
    return jnp.moveaxis(o, 0, 1).reshape(b, lc, h * d)


def neighbourhood_attention(q, k, v, k_ctx, v_ctx, rpb):
    b, l, h, d = q.shape
    rows = l // GRID_W
    wh = min(NA_WIN_H, rows)
    ww = NA_WIN_W
    n_keys = wh * ww
    cols = jnp.arange(GRID_W)
    col_start = jnp.clip(cols - ww // 2, 0, GRID_W - ww)
    key_cols = col_start[:, None] + jnp.arange(ww)[None, :]
    col_off = key_cols - cols[:, None] + (NA_WIN_W - 1)
    q_rows = jnp.moveaxis(q.reshape(b, rows, GRID_W, h, d), 1, 0)

    def row_block(args):
        r, qr = args
        row_start = jnp.clip(r - wh // 2, 0, rows - wh)
        key_rows = row_start + jnp.arange(wh)
        idx = (key_rows[None, :, None] * GRID_W + key_cols[:, None, :]).reshape(GRID_W * n_keys)
        kw = jnp.take(k, idx, axis=1).reshape(b, GRID_W, n_keys, h, d)
        vw = jnp.take(v, idx, axis=1).reshape(b, GRID_W, n_keys, h, d)
        row_off = key_rows - r + (NA_WIN_H - 1)
        bias = rpb[:, row_off[:, None, None], col_off[None, :, :]]
        bias = jnp.transpose(bias, (0, 2, 1, 3)).reshape(h, GRID_W, n_keys).astype(jnp.float32)
        s_loc = jnp.einsum('bwhd,bwkhd->bhwk', qr, kw).astype(jnp.float32) + bias
        s_ctx = jnp.einsum('bwhd,bshd->bhws', qr, k_ctx).astype(jnp.float32)
        p = jax.nn.softmax(jnp.concatenate([s_loc, s_ctx], axis=-1), axis=-1).astype(v.dtype)
        return (jnp.einsum('bhwk,bwkhd->bwhd', p[..., :n_keys], vw)
                + jnp.einsum('bhws,bshd->bwhd', p[..., n_keys:], v_ctx))

    o = lax.map(row_block, (jnp.arange(rows), q_rows))
    return jnp.moveaxis(o, 0, 1).reshape(b, l, h * d)


def swiglu(h, wg, wu, wd):
    return (jax.nn.silu(h @ wg) * (h @ wu)) @ wd


def block_tail(x, hm, y_ret, y_na, g1, sh2, sc2, g2, w_ret_out, w_na_out, w_gate, w_o,
               n_post_mix, n_pre_ffn, n_post_ffn, w_ffn_gate, w_ffn_up, w_ffn_down):
    g_ret, g_na = jnp.split(jax.nn.sigmoid(hm @ w_gate), 2, axis=-1)
    mixed = (g_ret * (y_ret @ w_ret_out) + g_na * (y_na @ w_na_out)) @ w_o
    x = x + g1[:, None, :] * rmsnorm(mixed, n_post_mix)
    hf = modulate(rmsnorm(x, n_pre_ffn), sh2, sc2)
    return x + g2[:, None, :] * rmsnorm(swiglu(hf, w_ffn_gate, w_ffn_up, w_ffn_down), n_post_ffn)


def setup_inputs(seed: int = 0) -> dict:
    key = jax.random.key(seed)
    ks = jax.random.split(key, 24)
    f32 = jnp.float32
    nrm = lambda k, shape, s: jax.random.normal(k, shape, f32) * s
    gamma0 = 1.0 - 2.0 ** (-5.0 - np.arange(RET_HEADS, dtype=np.float32))
    logit0 = jnp.asarray(np.log(gamma0 / (1.0 - gamma0)), f32)
    return {
        'x_prompt': nrm(ks[0], (BATCH, SEQ, D_MODEL), 1.0),
        'x_sample': nrm(ks[1], (DEC_BATCH, DEC_SEQ, D_MODEL), 1.0),
        'cache_na_k': nrm(ks[2], (DEC_BATCH, DEPTH, PAST_LEN, NA_HEADS, NA_DH), 1.0),
        'cache_na_v': nrm(ks[3], (DEC_BATCH, DEPTH, PAST_LEN, NA_HEADS, NA_DH), 1.0),
        'state_ret': nrm(ks[4], (DEC_BATCH, DEPTH, 2, RET_HEADS, RET_DK, RET_DV), 0.5),
        'c': nrm(ks[5], (DEC_BATCH, D_MODEL), 1.0),
        'c_ctx': nrm(ks[6], (D_MODEL,), 1.0),
        'w_ada': nrm(ks[7], (DEPTH, D_MODEL, 6 * D_MODEL), 0.5 * D_MODEL ** -0.5),
        'b_ada': nrm(ks[8], (DEPTH, 6 * D_MODEL), 0.01),
        'norm_pre_mix': 1.0 + nrm(ks[9], (DEPTH, D_MODEL), 0.05),
        'norm_post_mix': 1.0 + nrm(ks[10], (DEPTH, D_MODEL), 0.05),
        'norm_pre_ffn': 1.0 + nrm(ks[11], (DEPTH, D_MODEL), 0.05),
        'norm_post_ffn': 1.0 + nrm(ks[12], (DEPTH, D_MODEL), 0.05),
        'w_in': nrm(ks[13], (DEPTH, D_MODEL, IN_WIDTH), D_MODEL ** -0.5),
        'ret_decay_logit': logit0[None, None, :] + nrm(ks[14], (DEPTH, 2, RET_HEADS), 0.1),
        'ret_gn_gain': 1.0 + nrm(ks[15], (DEPTH, RET_V_W), 0.05),
        'na_rpb': nrm(ks[16], (DEPTH, NA_HEADS, 2 * NA_WIN_H - 1, 2 * NA_WIN_W - 1), 0.02),
        'w_ret_out': nrm(ks[17], (DEPTH, RET_V_W, D_MODEL), RET_V_W ** -0.5),
        'w_na_out': nrm(ks[18], (DEPTH, NA_W, D_MODEL), NA_W ** -0.5),
        'w_gate': nrm(ks[19], (DEPTH, D_MODEL, 2 * D_MODEL), D_MODEL ** -0.5),
        'w_o': nrm(ks[20], (DEPTH, D_MODEL, D_MODEL), D_MODEL ** -0.5),
        'w_ffn_gate': nrm(ks[21], (DEPTH, D_MODEL, D_FF), D_MODEL ** -0.5),
        'w_ffn_up': nrm(ks[22], (DEPTH, D_MODEL, D_FF), D_MODEL ** -0.5),
        'w_ffn_down': nrm(ks[23], (DEPTH, D_FF, D_MODEL), D_FF ** -0.5),
    }


def reference(x_prompt, x_sample, cache_na_k, cache_na_v, state_ret, c, c_ctx, w_ada, b_ada,
              norm_pre_mix, norm_post_mix, norm_pre_ffn, norm_post_ffn, w_in, ret_decay_logit,
              ret_gn_gain, na_rpb, w_ret_out, w_na_out, w_gate, w_o, w_ffn_gate, w_ffn_up,
              w_ffn_down):
    f32 = jnp.float32
    q_scale = NA_DH ** -0.5
    k_scale = RET_DK ** -0.5

    x = x_prompt
    b_p = x.shape[0]
    k_list, v_list, s_list = [], [], []
    for l in range(DEPTH):
        sh1, sc1, g1, sh2, sc2, g2 = adaln(c_ctx[None, :], w_ada[l], b_ada[l])
        hm = modulate(rmsnorm(x, norm_pre_mix[l]), sh1, sc1)
        rq, rk, rv, rg, nq, nk, nv = project_in(hm, w_in[l])
        log_g = jax.nn.log_sigmoid(ret_decay_logit[l].astype(f32))
        s0 = jnp.zeros((b_p, RET_HEADS, RET_DK, RET_DV), f32)
        y, s_f, s_b = retention_bidir(rq.astype(f32), rk.astype(f32) * k_scale, rv.astype(f32),
                                      log_g, s0, s0)
        y_ret = retention_output(y, rg, ret_gn_gain[l])
        y_na = context_attention(nq * q_scale, nk, nv)
        x = block_tail(x, hm, y_ret, y_na, g1, sh2, sc2, g2, w_ret_out[l], w_na_out[l], w_gate[l],
                       w_o[l], norm_post_mix[l], norm_pre_ffn[l], norm_post_ffn[l],
                       w_ffn_gate[l], w_ffn_up[l], w_ffn_down[l])
        k_list.append(nk)
        v_list.append(nv)
        s_list.append(jnp.stack([s_f, s_b], axis=1).astype(x_prompt.dtype))
    y_prompt = x
    new_cache_na_k = jnp.stack(k_list, axis=1)
    new_cache_na_v = jnp.stack(v_list, axis=1)
    new_state_ret = jnp.stack(s_list, axis=1)

    x = x_sample
    for l in range(DEPTH):
        sh1, sc1, g1, sh2, sc2, g2 = adaln(c, w_ada[l], b_ada[l])
        hm = modulate(rmsnorm(x, norm_pre_mix[l]), sh1, sc1)
        rq, rk, rv, rg, nq, nk, nv = project_in(hm, w_in[l])
        rq = rope_2d(rq)
        rk = rope_2d(rk)
        log_g = jax.nn.log_sigmoid(ret_decay_logit[l].astype(f32))
        y, _, _ = retention_bidir(rq.astype(f32), rk.astype(f32) * k_scale, rv.astype(f32), log_g,
                                  state_ret[:, l, 0].astype(f32), state_ret[:, l, 1].astype(f32))
        y_ret = retention_output(y, rg, ret_gn_gain[l])
        y_na = neighbourhood_attention(nq * q_scale, nk, nv, cache_na_k[:, l], cache_na_v[:, l],
                                       na_rpb[l])
        x = block_tail(x, hm, y_ret, y_na, g1, sh2, sc2, g2, w_ret_out[l], w_na_out[l], w_gate[l],
                       w_o[l], norm_post_mix[l], norm_pre_ffn[l], norm_post_ffn[l],
                       w_ffn_gate[l], w_ffn_up[l], w_ffn_down[l])
    y_sample = x
    return (y_prompt, y_sample, new_cache_na_k, new_cache_na_v, new_state_ret)
```

```cpp
#include <hip/hip_runtime.h>
#include <hip/hip_cooperative_groups.h>
#include <cstdio>
namespace cg = cooperative_groups;

typedef unsigned short u16;
using bf16x8 = __attribute__((ext_vector_type(8))) short;
using f32x4 = __attribute__((ext_vector_type(4))) float;
using i32x4 = __attribute__((ext_vector_type(4))) int;
using u32x2 = __attribute__((ext_vector_type(2))) unsigned;

#ifndef DUPMASK
#define DUPMASK 0
#endif
#define NTHREADS 256
#define NG 2
#define TG 12288
#define DM 1024
#define DFF 2816
#define EPSV 1e-6f

__host__ __device__ constexpr int g_ctx_nb(int g) { return g == 0 ? 32 : 0; }
__host__ __device__ constexpr int g_smp_b0(int g) { return g == 0 ? 0 : 2; }
__host__ __device__ constexpr int g_smp_nb(int g) { return g == 0 ? 2 : 6; }

struct Params {
  const float *x_prompt, *x_sample, *cache_k, *cache_v, *state_ret, *c, *c_ctx, *w_ada, *b_ada;
  const float *n_pre_mix, *n_post_mix, *n_pre_ffn, *n_post_ffn, *w_in, *decay_logit, *gn_gain, *rpb;
  const float *w_ret_out, *w_na_out, *w_gate, *w_o, *w_ffn_gate, *w_ffn_up, *w_ffn_down;
  float* out;
  char* ws;
};


#define OUT_YP 0L
#define OUT_YS 8388608L
#define OUT_NK 25165824L
#define OUT_NV 33554432L
#define OUT_ST 41943040L

__device__ __forceinline__ int opaque_tid() { int t = threadIdx.x; asm volatile("" : "+v"(t)); return t; }
typedef __bf16 bf16x2_t __attribute__((ext_vector_type(2)));
typedef float f32x2_t __attribute__((ext_vector_type(2)));
__device__ __forceinline__ unsigned pk2(float a, float b) {
  f32x2_t v = {a, b};
  bf16x2_t r = __builtin_convertvector(v, bf16x2_t);
  return __builtin_bit_cast(unsigned, r);
}
__device__ __forceinline__ u16 f2bf(float f) { return (u16)(pk2(f, 0.f) & 0xffffu); }
__device__ __forceinline__ float bf2f(u16 h) { return __uint_as_float(((unsigned)h) << 16); }
__device__ __forceinline__ u32x2 pack4(f32x4 v) { u32x2 r; r.x = pk2(v[0], v[1]); r.y = pk2(v[2], v[3]); return r; }
__device__ __forceinline__ void unpack4(u32x2 v, float (&o)[4]) {
  o[0] = bf2f((u16)(v.x & 0xffff)); o[1] = bf2f((u16)(v.x >> 16)); o[2] = bf2f((u16)(v.y & 0xffff)); o[3] = bf2f((u16)(v.y >> 16));
}
__device__ __forceinline__ f32x4 unpack4v(u32x2 v) {
  f32x4 o; o[0] = bf2f((u16)(v.x & 0xffff)); o[1] = bf2f((u16)(v.x >> 16)); o[2] = bf2f((u16)(v.y & 0xffff)); o[3] = bf2f((u16)(v.y >> 16)); return o;
}
__device__ __forceinline__ float shfl_xor_l(float v, int mask, int lane) {
  return __int_as_float(__builtin_amdgcn_ds_bpermute((lane ^ mask) << 2, __float_as_int(v)));
}
__device__ __forceinline__ float wave_sum(float v) {
  const int lane = opaque_tid() & 63;
#pragma unroll
  for (int o = 1; o < 64; o <<= 1) v += shfl_xor_l(v, o, lane);
  return v;
}
__device__ __forceinline__ float siluf(float x) { return x / (1.f + __expf(-x)); }
__device__ __forceinline__ float sigmf(float x) { return 1.f / (1.f + __expf(-x)); }
__device__ __forceinline__ float log_sigmoid(float x) { return fminf(x, 0.f) - log1pf(expf(-fabsf(x))); }

__device__ __forceinline__ int tperm32(int k) { return ((k & 15) >> 2) * 8 + (k >> 4) * 4 + (k & 3); }
__device__ __forceinline__ int tcol_of(int t) { return (t & ~31) | tperm32(t & 31); }
__device__ __forceinline__ int gtok_of(int g, int t) {
  const int nc = g_ctx_nb(g) * 256;
  return t < nc ? t : 8192 + g_smp_b0(g) * 2048 + (t - nc);
}
__device__ __forceinline__ int modidx_of(int g, int t) {
  const int nc = g_ctx_nb(g) * 256;
  return t < nc ? 0 : 1 + g_smp_b0(g) + (t - nc) / 2048;
}

__device__ __forceinline__ int lds_byte(int r, int c) {
  int st = (r >> 4) * 2 + (c >> 5), ob = (r & 15) * 64 + (c & 31) * 2;
  return st * 1024 + (ob ^ (((ob >> 9) & 1) << 5));
}

__device__ __forceinline__ void gemm_kloop(f32x4 (&acc)[4][4], const u16* X, int ldx, const u16* W, int ldw, int K, char* lds) {
  const int tid = opaque_tid(), wid = tid >> 6, lane = tid & 63;
  const int fr = lane & 15, fq = lane >> 4;
  const int wn = wid >> 1, wm = wid & 1;
  const int sb = lane * 16;
  const int swz = sb ^ (((sb >> 9) & 1) << 5);
  const int rbase = (wid >> 1) * 16 + (swz >> 6);
  const int cc = (wid & 1) * 32 + ((swz & 63) >> 1);
  const u16* xs = X + (long)rbase * ldx + cc;
  const u16* wsrc = W + (long)rbase * ldw + cc;
  const int soff = wid * 1024 + lane * 16;
  i32x4 sx[4], sw[4];
  const int nt = K >> 6;
#define G_ISSUE(kt_)                                                        \
  _Pragma("unroll") for (int i = 0; i < 4; ++i) {                           \
    sx[i] = *(const i32x4*)(xs + (long)(32 * i) * ldx + (kt_) * 64);        \
    sw[i] = *(const i32x4*)(wsrc + (long)(32 * i) * ldw + (kt_) * 64);      \
  }
#define G_WRITE(b_)                                                         \
  _Pragma("unroll") for (int i = 0; i < 4; ++i) {                           \
    *(i32x4*)(lds + (b_) * 32768 + soff + i * 4096) = sx[i];                \
    *(i32x4*)(lds + (b_) * 32768 + 16384 + soff + i * 4096) = sw[i];        \
  }
  G_ISSUE(0);
  G_WRITE(0);
  if (nt > 1) { G_ISSUE(1); }
  __syncthreads();
  for (int t = 0; t < nt; ++t) {
    const int cur = t & 1;
    if (t + 1 < nt) { G_WRITE(cur ^ 1); }
    if (t + 2 < nt) { G_ISSUE(t + 2); }
    const char* sX = lds + cur * 32768;
    const char* sW = sX + 16384;
#pragma unroll
    for (int ks = 0; ks < 2; ++ks) {
      bf16x8 wf[4], xf[4];
#pragma unroll
      for (int i = 0; i < 4; ++i) wf[i] = *(const bf16x8*)(sW + lds_byte(wn * 64 + i * 16 + fr, ks * 32 + fq * 8));
#pragma unroll
      for (int j = 0; j < 4; ++j) xf[j] = *(const bf16x8*)(sX + lds_byte(wm * 64 + j * 16 + fr, ks * 32 + fq * 8));
#pragma unroll
      for (int i = 0; i < 4; ++i)
#pragma unroll
        for (int j = 0; j < 4; ++j) acc[i][j] = __builtin_amdgcn_mfma_f32_16x16x32_bf16(wf[i], xf[j], acc[i][j], 0, 0, 0);
    }
    __syncthreads();
  }
#undef G_ISSUE
#undef G_WRITE
}

__device__ __forceinline__ void zero_acc(f32x4 (&acc)[4][4]) {
#pragma unroll
  for (int i = 0; i < 4; ++i)
#pragma unroll
    for (int j = 0; j < 4; ++j) acc[i][j] = f32x4{0.f, 0.f, 0.f, 0.f};
}


__device__ __forceinline__ int lds_byte32(int r, int c) {
  int ob = (r & 15) * 64 + c * 2;
  return (r >> 4) * 1024 + (ob ^ (((ob >> 9) & 1) << 5));
}
template <int NJ>
__device__ __forceinline__ void gemm_kloopN(f32x4 (&acc)[4][NJ], const u16* X, int ldx, const u16* W, int ldw, int K, char* lds) {
  constexpr int NXL = NJ / 2;
  constexpr int JH = NJ / 2;
  const int tid = opaque_tid(), wid = tid >> 6, lane = tid & 63;
  const int fr = lane & 15, fq = lane >> 4;
  const int wn = wid >> 1, wm = wid & 1;
  const int sb = lane * 16;
  const int swz = sb ^ (((sb >> 9) & 1) << 5);
  const int rr = swz >> 6, cc = (swz & 63) >> 1;
  const u16* xs = X + (long)(wid * NXL * 16 + rr) * ldx + cc;
  const u16* wsrc = W + (long)(wid * 32 + rr) * ldw + cc;
  const int soff = lane * 16;
  i32x4 sx[NXL], sw[2];
  const int nt = K >> 5;
#define G8_ISSUE(kt_)                                                                         \
  _Pragma("unroll") for (int i = 0; i < NXL; ++i) sx[i] = *(const i32x4*)(xs + (long)(16 * i) * ldx + (kt_) * 32); \
  _Pragma("unroll") for (int i = 0; i < 2; ++i) sw[i] = *(const i32x4*)(wsrc + (long)(16 * i) * ldw + (kt_) * 32);
#define G8_WRITE(b_)                                                                          \
  _Pragma("unroll") for (int i = 0; i < NXL; ++i) *(i32x4*)(lds + (b_) * 24576 + (wid * NXL + i) * 1024 + soff) = sx[i]; \
  _Pragma("unroll") for (int i = 0; i < 2; ++i) *(i32x4*)(lds + (b_) * 24576 + 16384 + (wid * 2 + i) * 1024 + soff) = sw[i];
  G8_ISSUE(0);
  G8_WRITE(0);
  if (nt > 1) { G8_ISSUE(1); }
  __syncthreads();
  for (int t = 0; t < nt; ++t) {
    const int cur = t & 1;
    if (t + 1 < nt) { G8_WRITE(cur ^ 1); }
    if (t + 2 < nt) { G8_ISSUE(t + 2); }
    const char* sX = lds + cur * 24576;
    const char* sW = sX + 16384;
    bf16x8 wf[4];
#pragma unroll
    for (int i = 0; i < 4; ++i) wf[i] = *(const bf16x8*)(sW + lds_byte32(wn * 64 + i * 16 + fr, fq * 8));
#pragma unroll
    for (int jh = 0; jh < 2; ++jh) {
      bf16x8 xf[JH];
#pragma unroll
      for (int j = 0; j < JH; ++j) xf[j] = *(const bf16x8*)(sX + lds_byte32(wm * (NJ * 16) + (jh * JH + j) * 16 + fr, fq * 8));
#pragma unroll
      for (int i = 0; i < 4; ++i)
#pragma unroll
        for (int j = 0; j < JH; ++j) acc[i][jh * JH + j] = __builtin_amdgcn_mfma_f32_16x16x32_bf16(wf[i], xf[j], acc[i][jh * JH + j], 0, 0, 0);
      __builtin_amdgcn_sched_barrier(0);
    }
    __syncthreads();
  }
#undef G8_ISSUE
#undef G8_WRITE
}
__device__ __forceinline__ void gemm_kloop8(f32x4 (&acc)[4][8], const u16* X, int ldx, const u16* W, int ldw, int K, char* lds) {
  gemm_kloopN<8>(acc, X, ldx, W, ldw, K, lds);
}
template <int NJ>
__device__ __forceinline__ void zero_accN(f32x4 (&acc)[4][NJ]) {
#pragma unroll
  for (int i = 0; i < 4; ++i)
#pragma unroll
    for (int j = 0; j < NJ; ++j) acc[i][j] = f32x4{0.f, 0.f, 0.f, 0.f};
}
__device__ __forceinline__ void zero_acc8(f32x4 (&acc)[4][8]) {
#pragma unroll
  for (int i = 0; i < 4; ++i)
#pragma unroll
    for (int j = 0; j < 8; ++j) acc[i][j] = f32x4{0.f, 0.f, 0.f, 0.f};
}

__device__ __forceinline__ void tr_job(const float* srcA, int ldA, const float* srcB, int ldB, u16* dst, int ldd, char* lds, bool permk = false) {
  u16(*tile)[72] = (u16(*)[72])lds;
  const int t = opaque_tid(), colj = t & 31, half = (t >> 5) & 1, kr = t >> 6;
  const float* s = half ? srcB : srcA;
  const int ld = half ? ldB : ldA;
#pragma unroll
  for (int i = 0; i < 16; ++i) {
    int kk = i * 4 + kr;
    const int kw = permk ? ((kk & 32) | tperm32(kk & 31)) : kk;
    tile[half * 32 + colj][kw] = f2bf(s[(long)kk * ld + colj]);
  }
  __syncthreads();
  const int n = t >> 2, ks = (t & 3) * 16;
  i32x4 a = *(const i32x4*)&tile[n][ks], b = *(const i32x4*)&tile[n][ks + 8];
  *(i32x4*)(dst + (long)n * ldd + ks) = a;
  *(i32x4*)(dst + (long)n * ldd + ks + 8) = b;
  __syncthreads();
}

#define WT1_SZ (4608L * 1024)
#define WTG_SZ (2048L * 1024)
#define WTR_SZ (1024L * 1024)
#define WTN_SZ (1024L * 512)
#define WTO_SZ (1024L * 1024)
#define WTGU_SZ (5632L * 1024)
#define WTD_SZ (1024L * 2816)

constexpr size_t al256(size_t x) { return (x + 255) & ~(size_t)255; }
constexpr size_t OFF_wt1 = 0;
constexpr size_t OFF_wt_g = OFF_wt1 + al256(2 * WT1_SZ * 2);
constexpr size_t OFF_wt_ret = OFF_wt_g + al256(2 * WTG_SZ * 2);
constexpr size_t OFF_wt_na = OFF_wt_ret + al256(2 * WTR_SZ * 2);
constexpr size_t OFF_wt_o = OFF_wt_na + al256(2 * WTN_SZ * 2);
constexpr size_t OFF_wt_gu = OFF_wt_o + al256(2 * WTO_SZ * 2);
constexpr size_t OFF_wt_dn = OFF_wt_gu + al256(2 * WTGU_SZ * 2);
constexpr size_t OFF_bar = OFF_wt_dn + al256(2 * WTD_SZ * 2);
constexpr size_t OFF_mod = OFF_bar + al256((3456 + 256) * 4);
constexpr size_t OFF_ropetab = OFF_mod + al256(2 * 9 * 6144 * 4);
constexpr size_t OFF_ckb = OFF_ropetab + al256(4096 * 4);
constexpr size_t OFF_cvt = OFF_ckb + al256(4194304L * 2);
constexpr size_t OFF_hm = OFF_cvt + al256(4194304L * 2);
constexpr size_t OFF_rq = OFF_hm + al256((size_t)TG * 1024 * 2);
constexpr size_t OFF_rk = OFF_rq + al256((size_t)TG * 512 * 2);
constexpr size_t OFF_vt = OFF_rk + al256((size_t)TG * 512 * 2);
constexpr size_t OFF_rg = OFF_vt + al256((size_t)TG * 1024 * 2);
constexpr size_t OFF_nq = OFF_rg + al256((size_t)TG * 1024 * 2);
constexpr size_t OFF_nk = OFF_nq + al256((size_t)TG * 512 * 2);
constexpr size_t OFF_nvt = OFF_nk + al256((size_t)TG * 512 * 2);
constexpr size_t OFF_kt = OFF_nvt + al256((size_t)TG * 512 * 2);
constexpr size_t OFF_ktb = OFF_kt + al256((size_t)TG * 512 * 2);
constexpr size_t OFF_St = OFF_ktb + al256((size_t)TG * 512 * 2);
constexpr size_t OFF_yret = OFF_St + al256((size_t)768 * 65536);
constexpr size_t OFF_yna = OFF_yret + al256((size_t)TG * 1024 * 2);
constexpr size_t WS_TOTAL = OFF_yna + al256((size_t)TG * 512 * 2);
constexpr size_t OFF_mbuf = OFF_rq;
constexpr size_t OFF_mixed = OFF_vt;
constexpr size_t OFF_ubuf = OFF_St;
constexpr size_t OFF_gbuf = OFF_nq;
#define P_wt1(p) ((u16*)((p).ws + OFF_wt1))
#define P_wt_g(p) ((u16*)((p).ws + OFF_wt_g))
#define P_wt_ret(p) ((u16*)((p).ws + OFF_wt_ret))
#define P_wt_na(p) ((u16*)((p).ws + OFF_wt_na))
#define P_wt_o(p) ((u16*)((p).ws + OFF_wt_o))
#define P_wt_gu(p) ((u16*)((p).ws + OFF_wt_gu))
#define P_wt_dn(p) ((u16*)((p).ws + OFF_wt_dn))
#define P_ckb(p) ((u16*)((p).ws + OFF_ckb))
#define P_cvt(p) ((u16*)((p).ws + OFF_cvt))
#define P_hm(p) ((u16*)((p).ws + OFF_hm))
#define P_rq(p) ((u16*)((p).ws + OFF_rq))
#define P_rk(p) ((u16*)((p).ws + OFF_rk))
#define P_kt(p) ((u16*)((p).ws + OFF_kt))
#define P_ktb(p) ((u16*)((p).ws + OFF_ktb))
#define P_vt(p) ((u16*)((p).ws + OFF_vt))
#define P_rg(p) ((u16*)((p).ws + OFF_rg))
#define P_nq(p) ((u16*)((p).ws + OFF_nq))
#define P_nk(p) ((u16*)((p).ws + OFF_nk))
#define P_nvt(p) ((u16*)((p).ws + OFF_nvt))
#define P_St(p) ((u16*)((p).ws + OFF_St))
#define P_yret(p) ((u16*)((p).ws + OFF_yret))
#define P_yna(p) ((u16*)((p).ws + OFF_yna))
#define P_mbuf(p) ((u16*)((p).ws + OFF_mbuf))
#define P_ubuf(p) ((u16*)((p).ws + OFF_ubuf))
#define P_gbuf(p) ((u16*)((p).ws + OFF_gbuf))
#define P_mod(p) ((float*)((p).ws + OFF_mod))
#define P_ropetab(p) ((float*)((p).ws + OFF_ropetab))
#define P_mixed(p) ((u16*)((p).ws + OFF_mixed))
#define P_bar(p) ((unsigned*)((p).ws + OFF_bar))

struct TrJob { const float* sA; int ldA; const float* sB; int ldB; u16* dst; int ldd; int permk; };
__device__ __forceinline__ TrJob tr_decode(const Params& p, int j) {
  const int JL = 1152 + 512 + 256 + 128 + 256 + 1408 + 704;
    if (j < 2 * JL) {
      const int l = j / JL;
      int r = j % JL;
      if (r < 1152) {
        int nt = r / 16, kt = r % 16, n0 = nt * 64, k0 = kt * 64, cA, cB;
        if (n0 < 1024) { int h8 = n0 / 128, blk = (n0 % 128) / 64; cA = h8 * 128 + blk * 32; cB = cA + 64; }
        else { cA = n0; cB = n0 + 32; }
        const float* src = p.w_in + (long)l * 1024 * 4608 + (long)k0 * 4608;
        return TrJob{src + cA, 4608, src + cB, 4608, P_wt1(p) + l * WT1_SZ + (long)n0 * 1024 + k0, 1024, 0};
      }
      r -= 1152;
      if (r < 512) {
        int nt = r / 16, kt = r % 16, n0 = nt * 64, k0 = kt * 64;
        const float* src = p.w_gate + (long)l * 1024 * 2048 + (long)k0 * 2048 + n0;
        return TrJob{src, 2048, src + 32, 2048, P_wt_g(p) + l * WTG_SZ + (long)n0 * 1024 + k0, 1024, 0};
      }
      r -= 512;
      if (r < 256) {
        int nt = r / 16, kt = r % 16, n0 = nt * 64, k0 = kt * 64;
        const float* src = p.w_ret_out + (long)l * 1024 * 1024 + (long)k0 * 1024 + n0;
        return TrJob{src, 1024, src + 32, 1024, P_wt_ret(p) + l * WTR_SZ + (long)n0 * 1024 + k0, 1024, 0};
      }
      r -= 256;
      if (r < 128) {
        int nt = r / 8, kt = r % 8, n0 = nt * 64, k0 = kt * 64;
        const float* src = p.w_na_out + (long)l * 512 * 1024 + (long)k0 * 1024 + n0;
        return TrJob{src, 1024, src + 32, 1024, P_wt_na(p) + l * WTN_SZ + (long)n0 * 512 + k0, 512, 0};
      }
      r -= 128;
      if (r < 256) {
        int nt = r / 16, kt = r % 16, n0 = nt * 64, k0 = kt * 64;
        const float* src = p.w_o + (long)l * 1024 * 1024 + (long)k0 * 1024 + n0;
        return TrJob{src, 1024, src + 32, 1024, P_wt_o(p) + l * WTO_SZ + (long)n0 * 1024 + k0, 1024, 0};
      }
      r -= 256;
      if (r < 1408) {
        int nt = r / 16, kt = r % 16, n0 = nt * 64, k0 = kt * 64;
        const float* sg = p.w_ffn_gate + (long)l * 1024 * DFF + (long)k0 * DFF + nt * 32;
        const float* su = p.w_ffn_up + (long)l * 1024 * DFF + (long)k0 * DFF + nt * 32;
        return TrJob{sg, DFF, su, DFF, P_wt_gu(p) + l * WTGU_SZ + (long)n0 * 1024 + k0, 1024, 0};
      }
      r -= 1408;
      {
        int nt = r / 44, kt = r % 44, n0 = nt * 64, k0 = kt * 64;
        const float* src = p.w_ffn_down + (long)l * DFF * 1024 + (long)k0 * 1024 + n0;
        return TrJob{src, 1024, src + 32, 1024, P_wt_dn(p) + l * WTD_SZ + (long)n0 * DFF + k0, DFF, 0};
      }
    } else {
      int r = j - 2 * JL;
      int m = r / 64, q = r % 64, nt = q / 8, kt = q % 8, n0 = nt * 64, k0 = kt * 64;
      const float* src = p.cache_v + (long)m * 262144 + (long)k0 * 512 + n0;
      return TrJob{src, 512, src + 32, 512, P_cvt(p) + (long)m * 262144 + (long)n0 * 512 + k0, 512, 1};
    }
}
__device__ __forceinline__ void tr_load(const TrJob& jb, float (&r)[16]) {
  const int t = opaque_tid(), colj = t & 31, half = (t >> 5) & 1, kr = t >> 6;
  const float* s = half ? jb.sB : jb.sA;
  const int ld = half ? jb.ldB : jb.ldA;
#pragma unroll
  for (int i = 0; i < 16; ++i) r[i] = s[(long)(i * 4 + kr) * ld + colj];
}
__device__ __forceinline__ void tr_store(const TrJob& jb, const float (&r)[16], char* lds) {
  u16(*tile)[72] = (u16(*)[72])lds;
  const int t = opaque_tid(), colj = t & 31, half = (t >> 5) & 1, kr = t >> 6;
#pragma unroll
  for (int i = 0; i < 16; ++i) {
    const int kk = i * 4 + kr;
    const int kw = jb.permk ? ((kk & 32) | tperm32(kk & 31)) : kk;
    tile[half * 32 + colj][kw] = f2bf(r[i]);
  }
  __syncthreads();
  const int n = t >> 2, ks = (t & 3) * 16;
  i32x4 a = *(const i32x4*)&tile[n][ks], b = *(const i32x4*)&tile[n][ks + 8];
  *(i32x4*)(jb.dst + (long)n * jb.ldd + ks) = a;
  *(i32x4*)(jb.dst + (long)n * jb.ldd + ks + 8) = b;
  __syncthreads();
}
__device__ __forceinline__ void phase0(const Params& p, char* lds, int bid, int nb) {
  const int JL = 1152 + 512 + 256 + 128 + 256 + 1408 + 704;
  const int NJ = 2 * JL + 1024;
  {
    int j = bid;
    TrJob cur = tr_decode(p, j < NJ ? j : 0);
    float ra[16];
    if (j < NJ) tr_load(cur, ra);
    for (; j < NJ; j += nb) {
      const int jn = j + nb;
      TrJob nx = tr_decode(p, jn < NJ ? jn : 0);
      float rb[16];
      if (jn < NJ) tr_load(nx, rb);
      tr_store(cur, ra, lds);
      cur = nx;
#pragma unroll
      for (int i = 0; i < 16; ++i) ra[i] = rb[i];
    }
  }
  {
    float* sv = (float*)lds;
    float* part = (float*)(lds + 36864);
    const int t = opaque_tid();
    for (int j = bid; j < 192; j += nb) {
      const int l = j / 96, n0 = (j % 96) * 64;
      for (int i = t; i < 9 * 1024; i += NTHREADS) {
        int v = i >> 10, k = i & 1023;
        float cv = v == 0 ? p.c_ctx[k] : p.c[(v - 1) * 1024 + k];
        sv[i] = cv / (1.f + expf(-cv));
      }
      __syncthreads();
      const int col = t & 63, kq = t >> 6;
      float a[9];
#pragma unroll
      for (int v = 0; v < 9; ++v) a[v] = 0.f;
      const float* w = p.w_ada + (long)l * 1024 * 6144 + (long)(kq * 256) * 6144 + n0 + col;
      for (int k0 = 0; k0 < 256; k0 += 16) {
        float wv[16];
#pragma unroll
        for (int kk = 0; kk < 16; ++kk) wv[kk] = w[(long)(k0 + kk) * 6144];
#pragma unroll
        for (int kk = 0; kk < 16; ++kk)
#pragma unroll
          for (int v = 0; v < 9; ++v) a[v] += sv[v * 1024 + kq * 256 + k0 + kk] * wv[kk];
      }
#pragma unroll
      for (int v = 0; v < 9; ++v) part[(kq * 9 + v) * 64 + col] = a[v];
      __syncthreads();
      for (int i = t; i < 9 * 64; i += NTHREADS) {
        int v = i >> 6, cI = i & 63;
        float s = part[(0 * 9 + v) * 64 + cI] + part[(1 * 9 + v) * 64 + cI] + part[(2 * 9 + v) * 64 + cI] + part[(3 * 9 + v) * 64 + cI];
        P_mod(p)[((long)l * 9 + v) * 6144 + n0 + cI] = s + p.b_ada[l * 6144 + n0 + cI];
      }
      __syncthreads();
    }
  }
  {
    const long n4 = 4194304L / 4;
    for (long i = (long)bid * NTHREADS + opaque_tid(); i < n4; i += (long)nb * NTHREADS) {
      f32x4 v = *(const f32x4*)(p.cache_k + i * 4);
      *(u32x2*)(P_ckb(p) + i * 4) = pack4(v);
    }
    for (int i = bid * NTHREADS + opaque_tid(); i < 2048; i += nb * NTHREADS) {
      int pos = i >> 5, f = i & 31;
      float inv = powf(10000.0f, -(float)f / 32.0f);
      float ang = (float)pos * inv;
      P_ropetab(p)[i] = cosf(ang);
      P_ropetab(p)[2048 + i] = sinf(ang);
    }
  }
}

__device__ __forceinline__ void phase_hm(const Params& p, int l, int g, int bid, int nb) {
  const int wid = opaque_tid() >> 6, lane = opaque_tid() & 63;
  const float* gw = p.n_pre_mix + l * 1024;
  for (int t = bid * 4 + wid; t < TG; t += nb * 4) {
    const int gt = gtok_of(g, t);
    const float* xrow = (l == 0) ? (gt < 8192 ? p.x_prompt + (long)gt * 1024 : p.x_sample + (long)(gt - 8192) * 1024)
                                 : p.out + (long)gt * 1024;
    const float* md = P_mod(p) + ((long)l * 9 + modidx_of(g, t)) * 6144;
    f32x4 v[4];
    float ss = 0.f;
#pragma unroll
    for (int i = 0; i < 4; ++i) {
      if (l == 0) v[i] = *(const f32x4*)(xrow + i * 256 + lane * 4);
      else v[i] = unpack4v(*(const u32x2*)((const u16*)xrow + i * 256 + lane * 4));
      ss += v[i][0] * v[i][0] + v[i][1] * v[i][1] + v[i][2] * v[i][2] + v[i][3] * v[i][3];
    }
    const float r = rsqrtf(wave_sum(ss) * (1.f / 1024.f) + EPSV);
#pragma unroll
    for (int i = 0; i < 4; ++i) {
      const int c = i * 256 + lane * 4;
      f32x4 gv = *(const f32x4*)(gw + c), sh = *(const f32x4*)(md + c), sc = *(const f32x4*)(md + 1024 + c), o;
#pragma unroll
      for (int q = 0; q < 4; ++q) o[q] = (v[i][q] * r * gv[q]) * (1.f + sc[q]) + sh[q];
      *(u32x2*)(P_hm(p) + (long)t * 1024 + c) = pack4(o);
    }
  }
}

__device__ __forceinline__ void phase_post_mix(const Params& p, int l, int g, int bid, int nb) {
  const int wid = opaque_tid() >> 6, lane = opaque_tid() & 63;
  const float* gpm = p.n_post_mix + l * 1024;
  const float* gpf = p.n_pre_ffn + l * 1024;
  for (int t = bid * 4 + wid; t < TG; t += nb * 4) {
    const int gt = gtok_of(g, t);
    const float* xrow = (l == 0) ? (gt < 8192 ? p.x_prompt + (long)gt * 1024 : p.x_sample + (long)(gt - 8192) * 1024)
                                 : p.out + (long)gt * 1024;
    const float* md = P_mod(p) + ((long)l * 9 + modidx_of(g, t)) * 6144;
    const u16* mrow = P_mixed(p) + (long)t * 1024;
    f32x4 mv[4], xv[4];
    float ss = 0.f;
#pragma unroll
    for (int i = 0; i < 4; ++i) {
      mv[i] = unpack4v(*(const u32x2*)(mrow + i * 256 + lane * 4));
      if (l == 0) xv[i] = *(const f32x4*)(xrow + i * 256 + lane * 4);
      else xv[i] = unpack4v(*(const u32x2*)((const u16*)xrow + i * 256 + lane * 4));
      ss += mv[i][0] * mv[i][0] + mv[i][1] * mv[i][1] + mv[i][2] * mv[i][2] + mv[i][3] * mv[i][3];
    }
    const float r = rsqrtf(wave_sum(ss) * (1.f / 1024.f) + EPSV);
    float s2 = 0.f;
#pragma unroll
    for (int i = 0; i < 4; ++i) {
      const int c = i * 256 + lane * 4;
      f32x4 gv = *(const f32x4*)(gpm + c), g1 = *(const f32x4*)(md + 2048 + c);
#pragma unroll
      for (int q = 0; q < 4; ++q) {
        xv[i][q] = xv[i][q] + g1[q] * (mv[i][q] * r * gv[q]);
        s2 += xv[i][q] * xv[i][q];
      }
      *(u32x2*)((u16*)(p.out + (long)gt * 1024) + c) = pack4(xv[i]);
    }
    const float r2 = rsqrtf(wave_sum(s2) * (1.f / 1024.f) + EPSV);
#pragma unroll
    for (int i = 0; i < 4; ++i) {
      const int c = i * 256 + lane * 4;
      f32x4 gv = *(const f32x4*)(gpf + c), sh = *(const f32x4*)(md + 3072 + c), sc = *(const f32x4*)(md + 4096 + c), o;
#pragma unroll
      for (int q = 0; q < 4; ++q) o[q] = (xv[i][q] * r2 * gv[q]) * (1.f + sc[q]) + sh[q];
      *(u32x2*)(P_hm(p) + (long)t * 1024 + c) = pack4(o);
    }
  }
}

__device__ __forceinline__ void phase_post_ffn(const Params& p, int l, int g, int bid, int nb) {
  const int wid = opaque_tid() >> 6, lane = opaque_tid() & 63;
  const float* gpf = p.n_post_ffn + l * 1024;
  for (int t = bid * 4 + wid; t < TG; t += nb * 4) {
    const int gt = gtok_of(g, t);
    float* xrow = p.out + (long)gt * 1024;
    const float* md = P_mod(p) + ((long)l * 9 + modidx_of(g, t)) * 6144;
    const u16* mrow = P_mixed(p) + (long)t * 1024;
    f32x4 mv[4], xb[4];
    float ss = 0.f;
#pragma unroll
    for (int i = 0; i < 4; ++i) {
      mv[i] = unpack4v(*(const u32x2*)(mrow + i * 256 + lane * 4));
      xb[i] = unpack4v(*(const u32x2*)((const u16*)xrow + i * 256 + lane * 4));
      ss += mv[i][0] * mv[i][0] + mv[i][1] * mv[i][1] + mv[i][2] * mv[i][2] + mv[i][3] * mv[i][3];
    }
    const float r = rsqrtf(wave_sum(ss) * (1.f / 1024.f) + EPSV);
#pragma unroll
    for (int i = 0; i < 4; ++i) {
      const int c = i * 256 + lane * 4;
      f32x4 gv = *(const f32x4*)(gpf + c), g2 = *(const f32x4*)(md + 5120 + c), xv = xb[i];
#pragma unroll
      for (int q = 0; q < 4; ++q) xv[q] = xv[q] + g2[q] * (mv[i][q] * r * gv[q]);
      if (l == 0) *(u32x2*)((u16*)xrow + c) = pack4(xv);
      else *(f32x4*)(xrow + c) = xv;
    }
  }
}

__device__ __forceinline__ void phase_proj(const Params& p, int l, int g, char* lds, int t_first, int t_end, int t_stride) {
  const int tid = opaque_tid(), wid = tid >> 6, lane = tid & 63, fr = lane & 15, fq = lane >> 4;
  const int wn = wid >> 1, wm = wid & 1;
  const int nc = g_ctx_nb(g) * 256;
  const int MT = TG / 256, NT = 4608 / 128;
  const u16* W = P_wt1(p) + l * WT1_SZ;
  const float kscale = 0.08838834764831845f, qscale = 0.125f;
  for (int tile = t_first; tile < t_end; tile += t_stride) {
    const int mt = tile % MT, ntl = tile / MT, m0 = mt * 256, n0 = ntl * 128;
    f32x4 acc[4][8];
    zero_acc8(acc);
    gemm_kloop8(acc, P_hm(p) + (long)m0 * 1024, 1024, W + (long)n0 * 1024, 1024, 1024, lds);
    const int nbk = n0 + wn * 64;
    const bool is_smp = m0 >= nc;
    if (nbk < 1024) {
      const int h8 = nbk >> 7, blk = (nbk >> 6) & 1, h = h8 & 3;
      const bool isk = h8 >= 4;
      const float lgf_ = log_sigmoid(p.decay_logit[(l * 2 + 0) * 4 + h]), lgb_ = log_sigmoid(p.decay_logit[(l * 2 + 1) * 4 + h]);
#pragma unroll
      for (int j = 0; j < 8; ++j) {
        const int tl = m0 + wm * 128 + j * 16 + fr;
        const int tc_ = tcol_of(tl);
        int pos = 0;
        if (is_smp) { int s = (tl - nc) & 2047; pos = blk == 0 ? (s >> 6) : (s & 63); }
#pragma unroll
        for (int i = 0; i < 2; ++i) {
          f32x4 v1 = acc[i][j], v2 = acc[i + 2][j], o1, o2;
          const int f0 = i * 16 + fq * 4;
          if (is_smp) {
            f32x4 cs = *(const f32x4*)(P_ropetab(p) + pos * 32 + f0), sn = *(const f32x4*)(P_ropetab(p) + 2048 + pos * 32 + f0);
#pragma unroll
            for (int q = 0; q < 4; ++q) { o1[q] = v1[q] * cs[q] - v2[q] * sn[q]; o2[q] = v1[q] * sn[q] + v2[q] * cs[q]; }
          } else { o1 = v1; o2 = v2; }
          const int d1 = blk * 32 + f0;
          if (!isk) {
            *(u32x2*)(P_rq(p) + (long)tl * 512 + h * 128 + d1) = pack4(o1);
            *(u32x2*)(P_rq(p) + (long)tl * 512 + h * 128 + d1 + 64) = pack4(o2);
          } else {
#pragma unroll
            for (int q = 0; q < 4; ++q) { o1[q] *= kscale; o2[q] *= kscale; }
            *(u32x2*)(P_rk(p) + (long)tl * 512 + h * 128 + d1) = pack4(o1);
            *(u32x2*)(P_rk(p) + (long)tl * 512 + h * 128 + d1 + 64) = pack4(o2);
            {
              const int pp = tl & 127;
              const float zf = __expf(lgf_ * (float)(127 - pp)), zb = __expf(lgb_ * (float)pp);
#pragma unroll
              for (int q = 0; q < 4; ++q) {
                P_kt(p)[(long)(h * 128 + d1 + q) * TG + tc_] = f2bf(o1[q] * zf);
                P_kt(p)[(long)(h * 128 + d1 + 64 + q) * TG + tc_] = f2bf(o2[q] * zf);
                P_ktb(p)[(long)(h * 128 + d1 + q) * TG + tc_] = f2bf(o1[q] * zb);
                P_ktb(p)[(long)(h * 128 + d1 + 64 + q) * TG + tc_] = f2bf(o2[q] * zb);
              }
            }
          }
        }
      }
    } else {
#pragma unroll
      for (int j = 0; j < 8; ++j) {
        const int tl = m0 + wm * 128 + j * 16 + fr;
#pragma unroll
        for (int i = 0; i < 4; ++i) {
          const int n = nbk + i * 16 + fq * 4;
          f32x4 v = acc[i][j];
          if (nbk < 2048) {
            const int e = n - 1024;
#pragma unroll
            for (int q = 0; q < 4; ++q) P_vt(p)[(long)(e + q) * TG + tcol_of(tl)] = f2bf(v[q]);
          } else if (nbk < 3072) {
            f32x4 o;
#pragma unroll
            for (int q = 0; q < 4; ++q) o[q] = siluf(v[q]);
            *(u32x2*)(P_rg(p) + (long)tl * 1024 + (n - 2048)) = pack4(o);
          } else if (nbk < 3584) {
            f32x4 o;
#pragma unroll
            for (int q = 0; q < 4; ++q) o[q] = v[q] * qscale;
            *(u32x2*)(P_nq(p) + (long)tl * 512 + (n - 3072)) = pack4(o);
          } else if (nbk < 4096) {
            *(u32x2*)(P_nk(p) + (long)tl * 512 + (n - 3584)) = pack4(v);
            if (!is_smp) {
              const int b = tl >> 8, s = tl & 255;
              *(f32x4*)(p.out + OUT_NK + (((long)b * 2 + l) * 256 + s) * 512 + (n - 3584)) = v;
            }
          } else {
            const int cI = n - 4096;
#pragma unroll
            for (int q = 0; q < 4; ++q) P_nvt(p)[(long)(cI + q) * TG + tcol_of(tl)] = f2bf(v[q]);
            if (!is_smp) {
              const int b = tl >> 8, s = tl & 255;
              *(f32x4*)(p.out + OUT_NV + (((long)b * 2 + l) * 256 + s) * 512 + cI) = v;
            }
          }
        }
      }
    }
  }
}

__device__ __forceinline__ long st_slot(int g, bool smp, int seq, int h, int dir, int c) {
  return smp ? (long)g_ctx_nb(g) * 16 + seq * 128 + (h * 2 + dir) * 16 + c : (long)seq * 16 + (h * 2 + dir) * 2 + c;
}

__device__ __forceinline__ void uchunk_unit(const Params& p, int l, int g, int unit, char* lds) {
  const int tid = opaque_tid(), wid = tid >> 6, lane = tid & 63, fr = lane & 15, fq = lane >> 4;
  const int wn = wid >> 1, wm = wid & 1;
  const int n_smp_units = g_smp_nb(g) * 128;
  const int nc = g_ctx_nb(g) * 256;
  if (unit < n_smp_units) {
    const int seq = unit >> 7, rem = unit & 127, h = rem >> 5, dir = (rem >> 4) & 1, c = rem & 15;
    const int tc = nc + seq * 2048 + c * 128;
    const u16* W = (dir == 0 ? P_kt(p) : P_ktb(p)) + (long)(h * 128) * TG + tc;
    const u16* X = P_vt(p) + (long)(h * 256) * TG + tc;
    f32x4 acc[4][8];
    zero_acc8(acc);
    gemm_kloop8(acc, X, TG, W, TG, 128, lds);
    u16* st = P_St(p) + st_slot(g, true, seq, h, dir, c) * 32768;
#pragma unroll
    for (int j = 0; j < 8; ++j) {
      const int e = wm * 128 + j * 16 + fr;
#pragma unroll
      for (int i = 0; i < 4; ++i) *(u32x2*)(st + (long)e * 128 + wn * 64 + i * 16 + fq * 4) = pack4(acc[i][j]);
    }
  } else {
    const int u2 = unit - n_smp_units, seq = u2 >> 3, rem = u2 & 7, h = rem >> 1, dir = rem & 1;
    const int c1 = dir == 0 ? 0 : 1, c2 = 1 - c1;
    const float gch = expf(log_sigmoid(p.decay_logit[(l * 2 + dir) * 4 + h]) * 128.f);
    const u16* Wb = (dir == 0 ? P_kt(p) : P_ktb(p)) + (long)(h * 128) * TG + seq * 256;
    const u16* Xb = P_vt(p) + (long)(h * 256) * TG + seq * 256;
    f32x4 acc[4][8];
    zero_acc8(acc);
    gemm_kloop8(acc, Xb + c1 * 128, TG, Wb + c1 * 128, TG, 128, lds);
    u16* st1 = P_St(p) + st_slot(g, false, seq, h, dir, c1) * 32768;
    u16* st2 = P_St(p) + st_slot(g, false, seq, h, dir, c2) * 32768;
#pragma unroll
    for (int j = 0; j < 8; ++j) {
      const int e = wm * 128 + j * 16 + fr;
#pragma unroll
      for (int i = 0; i < 4; ++i) {
        const long o = (long)e * 128 + wn * 64 + i * 16 + fq * 4;
        u32x2 z; z.x = 0u; z.y = 0u;
        *(u32x2*)(st1 + o) = z;
        *(u32x2*)(st2 + o) = pack4(acc[i][j]);
        acc[i][j] *= gch;
      }
    }
    gemm_kloop8(acc, Xb + c2 * 128, TG, Wb + c2 * 128, TG, 128, lds);
    float* so = p.out + OUT_ST + ((((long)seq * 2 + l) * 2 + dir) * 4 + h) * 32768;
#pragma unroll
    for (int j = 0; j < 8; ++j) {
      const int e = wm * 128 + j * 16 + fr;
#pragma unroll
      for (int i = 0; i < 4; ++i)
#pragma unroll
        for (int q = 0; q < 4; ++q) so[(long)(wn * 64 + i * 16 + fq * 4 + q) * 256 + e] = acc[i][j][q];
    }
  }
}

template <int NCH>
__device__ __forceinline__ void prefix_item(u16* base, long cstride, bool rev, float gch, f32x4& S) {
  u32x2 u[NCH];
#pragma unroll
  for (int s = 0; s < NCH; ++s) u[s] = *(const u32x2*)(base + (long)(rev ? NCH - 1 - s : s) * cstride);
#pragma unroll
  for (int s = 0; s < NCH; ++s) {
    *(u32x2*)(base + (long)(rev ? NCH - 1 - s : s) * cstride) = pack4(S);
    float uf[4];
    unpack4(u[s], uf);
#pragma unroll
    for (int q = 0; q < 4; ++q) S[q] = gch * S[q] + uf[q];
  }
}
__device__ __forceinline__ void phase_prefix(const Params& p, int l, int g, int bid, int nb) {
  const int tid = opaque_tid();
  const int n_ch = g_smp_nb(g) * 8;
  for (int it = bid * NTHREADS + tid; it < n_ch * 8192; it += nb * NTHREADS) {
    const int chain = it >> 13, idx = it & 8191, e = idx >> 5, dq = idx & 31;
    const int seq = chain >> 3, h = (chain >> 1) & 3, dir = chain & 1;
    const float gch = expf(log_sigmoid(p.decay_logit[(l * 2 + dir) * 4 + h]) * 128.f);
    u16* base = P_St(p) + st_slot(g, true, seq, h, dir, 0) * 32768 + (long)e * 128 + dq * 4;
    const int bglob = g_smp_b0(g) + seq;
    const float* s0 = p.state_ret + ((((long)bglob * 2 + l) * 2 + dir) * 4 + h) * 32768 + e;
    f32x4 S;
#pragma unroll
    for (int q = 0; q < 4; ++q) S[q] = s0[(long)(dq * 4 + q) * 256];
    prefix_item<16>(base, 32768, dir == 1, gch, S);
  }
}

struct AttnCtx {
  const u16 *nk, *nvt, *ck, *cv;
  const float* rpb;
  int h, seqtok0, row_start, r, smp, wq, cs, fr, fq;
};
#define AT_STG 18432
__device__ __forceinline__ void at_issue(const AttnCtx& c, int t, int tid, i32x4 (&R)[4]) {
  const bool local = !c.smp || t < 8;
  const u16 *kbase, *vbase; int ldv;
  if (local) {
    const int key0 = c.smp ? c.seqtok0 + (c.row_start + t) * 64 : c.seqtok0 + t * 64;
    kbase = c.nk + (long)key0 * 512 + c.h * 64;
    vbase = c.nvt + (long)(c.h * 64) * TG + key0; ldv = TG;
  } else {
    const int key0 = (t - 8) * 64;
    kbase = c.ck + (long)key0 * 512 + c.h * 64;
    vbase = c.cv + (long)(c.h * 64) * 512 + key0; ldv = 512;
  }
  const int row = (tid >> 3) & 31, ch = tid & 7;
  const unsigned koff = (unsigned)(row * 512 + ch * 8), voff = (unsigned)(row * ldv + ch * 8);
  R[0] = *(const i32x4*)(kbase + koff);
  R[1] = *(const i32x4*)(kbase + 32 * 512 + koff);
  R[2] = *(const i32x4*)(vbase + voff);
  R[3] = *(const i32x4*)(vbase + (long)32 * ldv + voff);
}
__device__ __forceinline__ void at_write(char* stage, int tid, const i32x4 (&R)[4]) {
  const int row = (tid >> 3) & 31, ch = tid & 7;
  char* d = stage + row * 144 + ch * 16;
  *(i32x4*)(d) = R[0];
  *(i32x4*)(d + 32 * 144) = R[1];
  *(i32x4*)(d + 9216) = R[2];
  *(i32x4*)(d + 9216 + 32 * 144) = R[3];
}
__device__ __forceinline__ void attn_compute(const AttnCtx& c, int t, const char* stage, const float* rtab,
                                             const bf16x8 (&qf)[2], f32x4 (&O)[4], float& mrun, float& lrun) {
  const char* kb = stage + c.fr * 144 + c.fq * 16;
  const char* vb = kb + 9216;
  f32x4 S[4];
#pragma unroll
  for (int sub = 0; sub < 4; ++sub) {
    S[sub] = f32x4{0.f, 0.f, 0.f, 0.f};
#pragma unroll
    for (int ks = 0; ks < 2; ++ks)
      S[sub] = __builtin_amdgcn_mfma_f32_16x16x32_bf16(*(const bf16x8*)(kb + sub * 16 * 144 + ks * 64), qf[ks], S[sub], 0, 0, 0);
  }
  if (c.smp && t < 8) {
    const int dr = c.row_start + t - c.r + 7;
    const float* rp = rtab + dr * 31;
#pragma unroll
    for (int sub = 0; sub < 4; ++sub)
#pragma unroll
      for (int q = 0; q < 4; ++q) {
        const int kc = sub * 16 + c.fq * 4 + q;
        const bool valid = kc >= c.cs && kc < c.cs + 16;
        const int bi = min(max(kc - c.wq + 15, 0), 30);
        S[sub][q] = valid ? S[sub][q] + rp[bi] : -1e30f;
      }
  }
  float mx = -1e30f;
#pragma unroll
  for (int sub = 0; sub < 4; ++sub)
#pragma unroll
    for (int q = 0; q < 4; ++q) mx = fmaxf(mx, S[sub][q]);
  { const int ln_ = c.fq * 16 + c.fr; mx = fmaxf(mx, shfl_xor_l(mx, 16, ln_)); mx = fmaxf(mx, shfl_xor_l(mx, 32, ln_)); }
  const float mnew = fmaxf(mrun, mx);
  const float alpha = __expf(mrun - mnew);
  mrun = mnew;
  float ps = 0.f;
#pragma unroll
  for (int sub = 0; sub < 4; ++sub)
#pragma unroll
    for (int q = 0; q < 4; ++q) { float e = __expf(S[sub][q] - mnew); S[sub][q] = e; ps += e; }
  lrun = lrun * alpha + ps;
#pragma unroll
  for (int d = 0; d < 4; ++d) O[d] *= alpha;
#pragma unroll
  for (int s = 0; s < 2; ++s) {
    i32x4 pc = {(int)pk2(S[2 * s][0], S[2 * s][1]), (int)pk2(S[2 * s][2], S[2 * s][3]),
                (int)pk2(S[2 * s + 1][0], S[2 * s + 1][1]), (int)pk2(S[2 * s + 1][2], S[2 * s + 1][3])};
    bf16x8 pf = __builtin_bit_cast(bf16x8, pc);
#pragma unroll
    for (int d = 0; d < 4; ++d)
      O[d] = __builtin_amdgcn_mfma_f32_16x16x32_bf16(*(const bf16x8*)(vb + d * 16 * 144 + s * 64), pf, O[d], 0, 0, 0);
  }
}

__device__ __forceinline__ void attn_unit(const Params& p, int l, int g, int unit, char* lds) {
  const int tid = opaque_tid(), w = tid >> 6, lane = tid & 63, fr = lane & 15, fq = lane >> 4;
  const int nc = g_ctx_nb(g) * 256;
  const int n_smp_units = g_smp_nb(g) * 256;
  AttnCtx c;
  int qtok0, ntile, bglob = 0;
  c.fr = fr; c.fq = fq; c.r = 0; c.row_start = 0;
  if (unit < n_smp_units) {
    c.smp = 1;
    const int sb = unit >> 8, rem = unit & 255;
    c.r = rem >> 3; c.h = rem & 7;
    c.seqtok0 = nc + sb * 2048;
    qtok0 = c.seqtok0 + c.r * 64;
    c.row_start = min(max(c.r - 4, 0), 24);
    ntile = 16;
    bglob = g_smp_b0(g) + sb;
  } else {
    c.smp = 0;
    const int u = unit - n_smp_units;
    const int b = u >> 5, rem = u & 31;
    c.h = rem >> 2;
    const int qt = rem & 3;
    c.seqtok0 = b * 256;
    qtok0 = c.seqtok0 + qt * 64;
    ntile = 4;
  }
  c.nk = P_nk(p); c.nvt = P_nvt(p);
  c.ck = P_ckb(p) + ((long)bglob * 2 + l) * 262144;
  c.cv = P_cvt(p) + ((long)bglob * 2 + l) * 262144;
  c.rpb = p.rpb + ((long)l * 8 + c.h) * 15 * 31;
  c.wq = w * 16 + fr;
  c.cs = min(max(c.wq - 8, 0), 48);
  const int qtok = qtok0 + w * 16 + fr;
  char* st0 = lds;
  char* st1 = lds + AT_STG;
  float* rtab = (float*)(lds + 2 * AT_STG);
  if (c.smp) for (int i = tid; i < 465; i += NTHREADS) rtab[i] = c.rpb[i];
  i32x4 R0[4], R1[4], R2[4], R3[4];
  at_issue(c, 0, tid, R0);
  bf16x8 qf[2];
#pragma unroll
  for (int ks = 0; ks < 2; ++ks) qf[ks] = *(const bf16x8*)(P_nq(p) + (long)qtok * 512 + c.h * 64 + ks * 32 + fq * 8);
  at_write(st0, tid, R0);
  at_issue(c, 1, tid, R1);
  at_issue(c, 2, tid, R2);
  at_issue(c, 3, tid, R3);
  if (ntile > 4) at_issue(c, 4, tid, R0);
  f32x4 O[4];
#pragma unroll
  for (int d = 0; d < 4; ++d) O[d] = f32x4{0.f, 0.f, 0.f, 0.f};
  float mrun = -1e30f, lrun = 0.f;
  __syncthreads();
  for (int t = 0; t < ntile; t += 4) {
    at_write(st1, tid, R1);
    if (t + 5 < ntile) at_issue(c, t + 5, tid, R1);
    attn_compute(c, t, st0, rtab, qf, O, mrun, lrun);
    __syncthreads();
    at_write(st0, tid, R2);
    if (t + 6 < ntile) at_issue(c, t + 6, tid, R2);
    attn_compute(c, t + 1, st1, rtab, qf, O, mrun, lrun);
    __syncthreads();
    at_write(st1, tid, R3);
    if (t + 7 < ntile) at_issue(c, t + 7, tid, R3);
    attn_compute(c, t + 2, st0, rtab, qf, O, mrun, lrun);
    __syncthreads();
    if (t + 4 < ntile) at_write(st0, tid, R0);
    if (t + 8 < ntile) at_issue(c, t + 8, tid, R0);
    attn_compute(c, t + 3, st1, rtab, qf, O, mrun, lrun);
    __syncthreads();
  }
  lrun += shfl_xor_l(lrun, 16, lane);
  lrun += shfl_xor_l(lrun, 32, lane);
  const float inv = 1.f / lrun;
#pragma unroll
  for (int d = 0; d < 4; ++d) {
    f32x4 o = O[d] * inv;
    *(u32x2*)(P_yna(p) + (long)qtok * 512 + c.h * 64 + d * 16 + fq * 4) = pack4(o);
  }
}

#define MIXA_QUEUE(q_, n_, CALL_)                                              \
  {                                                                             \
    int nxt = 0;                                                                \
    if (t0) nxt = (int)atomicAdd(&ctr[q_], 1u);                                 \
    for (;;) {                                                                  \
      if (t0) *snext = nxt;                                                     \
      __syncthreads();                                                          \
      const int u = __builtin_amdgcn_readfirstlane(*snext);                     \
      __syncthreads();                                                          \
      if (u >= (n_)) break;                                                     \
      if (t0) nxt = (int)atomicAdd(&ctr[q_], 1u);                               \
      CALL_;                                                                    \
    }                                                                           \
  }
__device__ __forceinline__ void phase_mix_a(const Params& p, int l, int g, char* lds, unsigned* ctr, bool upper) {
  const int n_rq = 4 * (TG / 256);
  const int n_scan = g_smp_nb(g) * 128 + g_ctx_nb(g) * 8;
  const int n_attn = g_smp_nb(g) * 256 + g_ctx_nb(g) * 32;
  volatile int* snext = (volatile int*)(lds + 65520);
  const bool t0 = opaque_tid() == 0;
  if (upper) MIXA_QUEUE(2, n_attn, attn_unit(p, l, g, u, lds))
  MIXA_QUEUE(0, n_rq, phase_proj(p, l, g, lds, u, u + 1, 1))
  MIXA_QUEUE(1, n_scan, uchunk_unit(p, l, g, u, lds))
  if (!upper) MIXA_QUEUE(2, n_attn, attn_unit(p, l, g, u, lds))
}

__device__ __forceinline__ void retout_unit(const Params& p, int l, int g, int unit, char* lds) {
  const int tid = opaque_tid(), w = tid >> 6, lane = tid & 63, fr = lane & 15, fq = lane >> 4;
  const int nc = g_ctx_nb(g) * 256;
  const int n_smp_units = g_smp_nb(g) * 128;
  bool smp;
  int seq, h, c, half;
  if (unit < n_smp_units) { smp = true; const int hn = n_smp_units >> 1; half = unit >= hn; const int idx = unit - half * hn; seq = idx >> 6; h = (idx >> 4) & 3; c = idx & 15; }
  else { smp = false; const int nctx = g_ctx_nb(g) * 16, hn = nctx >> 1; const int u = unit - n_smp_units; half = u >= hn; const int idx = u - half * hn; seq = idx >> 3; h = (idx >> 1) & 3; c = idx & 1; }
  const int tok0 = smp ? nc + seq * 2048 : seq * 256;
  const int tc = tok0 + c * 128;
  const float lgf = log_sigmoid(p.decay_logit[(l * 2 + 0) * 4 + h]);
  const float lgb = log_sigmoid(p.decay_logit[(l * 2 + 1) * 4 + h]);
  char* bfr = lds;
  float* red = (float*)(lds + 49152);
  {
    const int pn = half * 64 + w * 16 + fr;
    const int qtok = tc + pn;
    bf16x8 qf[4];
#pragma unroll
    for (int ks = 0; ks < 4; ++ks) qf[ks] = *(const bf16x8*)(P_rq(p) + (long)qtok * 512 + h * 128 + ks * 32 + fq * 8);
#pragma unroll
    for (int s = 0; s < 4; ++s) {
      f32x4 sc[2];
#pragma unroll
      for (int k2 = 0; k2 < 2; ++k2) {
        const int ktile = 2 * s + k2;
        sc[k2] = f32x4{0.f, 0.f, 0.f, 0.f};
#pragma unroll
        for (int ks = 0; ks < 4; ++ks) {
          bf16x8 kf = *(const bf16x8*)(P_rk(p) + (long)(tc + ktile * 16 + fr) * 512 + h * 128 + ks * 32 + fq * 8);
          sc[k2] = __builtin_amdgcn_mfma_f32_16x16x32_bf16(kf, qf[ks], sc[k2], 0, 0, 0);
        }
#pragma unroll
        for (int q = 0; q < 4; ++q) {
          const int pm = ktile * 16 + fq * 4 + q;
          const int diff = pn - pm;
          float dcy = diff > 0 ? __expf(lgf * (float)diff) : (diff < 0 ? __expf(lgb * (float)(-diff)) : 2.0f);
          sc[k2][q] *= dcy;
        }
      }
      i32x4 pc = {(int)pk2(sc[0][0], sc[0][1]), (int)pk2(sc[0][2], sc[0][3]), (int)pk2(sc[1][0], sc[1][1]), (int)pk2(sc[1][2], sc[1][3])};
      *(i32x4*)(bfr + ((w * 12 + s) * 64 + lane) * 16) = pc;
    }
    const float xif = __expf(lgf * (float)(pn + 1)), xib = __expf(lgb * (float)(128 - pn));
#pragma unroll
    for (int ks = 0; ks < 4; ++ks) {
      float qv[8];
#pragma unroll
      for (int e8 = 0; e8 < 8; ++e8) qv[e8] = bf2f((u16)qf[ks][e8]);
      i32x4 xf = {(int)pk2(qv[0] * xif, qv[1] * xif), (int)pk2(qv[2] * xif, qv[3] * xif), (int)pk2(qv[4] * xif, qv[5] * xif), (int)pk2(qv[6] * xif, qv[7] * xif)};
      i32x4 xb = {(int)pk2(qv[0] * xib, qv[1] * xib), (int)pk2(qv[2] * xib, qv[3] * xib), (int)pk2(qv[4] * xib, qv[5] * xib), (int)pk2(qv[6] * xib, qv[7] * xib)};
      *(i32x4*)(bfr + ((w * 12 + 4 + ks) * 64 + lane) * 16) = xf;
      *(i32x4*)(bfr + ((w * 12 + 8 + ks) * 64 + lane) * 16) = xb;
    }
  }
  __syncthreads();
  const u16* stf = P_St(p) + st_slot(g, smp, seq, h, 0, c) * 32768;
  const u16* stb = P_St(p) + st_slot(g, smp, seq, h, 1, c) * 32768;
  f32x4 acc[4][4];
#pragma unroll
  for (int es = 0; es < 4; ++es) {
    const int erow = (w * 4 + es) * 16 + fr;
    const u16* vrow = P_vt(p) + (long)(h * 256 + erow) * TG + tc + fq * 8;
    const u16* sfr = stf + (long)erow * 128 + fq * 8;
    const u16* sbr = stb + (long)erow * 128 + fq * 8;
    bf16x8 af[12];
#pragma unroll
    for (int k = 0; k < 4; ++k) { af[k] = *(const bf16x8*)(vrow + k * 32); af[4 + k] = *(const bf16x8*)(sfr + k * 32); af[8 + k] = *(const bf16x8*)(sbr + k * 32); }
#pragma unroll
    for (int qs = 0; qs < 4; ++qs) {
      f32x4 a = f32x4{0.f, 0.f, 0.f, 0.f};
#pragma unroll
      for (int k = 0; k < 12; ++k)
        a = __builtin_amdgcn_mfma_f32_16x16x32_bf16(af[k], *(const bf16x8*)(bfr + ((qs * 12 + k) * 64 + lane) * 16), a, 0, 0, 0);
      acc[es][qs] = a;
    }
    __builtin_amdgcn_sched_barrier(0);
  }
#pragma unroll
  for (int qs = 0; qs < 4; ++qs) {
    float s1 = 0.f, s2 = 0.f;
#pragma unroll
    for (int es = 0; es < 4; ++es)
#pragma unroll
      for (int q = 0; q < 4; ++q) { const float v = acc[es][qs][q]; s1 += v; s2 += v * v; }
    s1 += shfl_xor_l(s1, 16, lane); s1 += shfl_xor_l(s1, 32, lane);
    s2 += shfl_xor_l(s2, 16, lane); s2 += shfl_xor_l(s2, 32, lane);
    if (fq == 0) { red[(w * 64 + qs * 16 + fr) * 2] = s1; red[(w * 64 + qs * 16 + fr) * 2 + 1] = s2; }
  }
  __syncthreads();
  const float* gn = p.gn_gain + l * 1024 + h * 256;
#pragma unroll
  for (int qs = 0; qs < 4; ++qs) {
    float s1 = 0.f, s2 = 0.f;
#pragma unroll
    for (int ww = 0; ww < 4; ++ww) { s1 += red[(ww * 64 + qs * 16 + fr) * 2]; s2 += red[(ww * 64 + qs * 16 + fr) * 2 + 1]; }
    const float mu = s1 * (1.f / 256.f);
    const float var = fmaxf(s2 * (1.f / 256.f) - mu * mu, 0.f);
    const float rstd = rsqrtf(var + EPSV);
    const int qtok = tc + half * 64 + qs * 16 + fr;
#pragma unroll
    for (int es = 0; es < 4; ++es) {
      const int e = (w * 4 + es) * 16 + fq * 4;
      f32x4 gv = *(const f32x4*)(gn + e);
      u32x2 gr = *(const u32x2*)(P_rg(p) + (long)qtok * 1024 + h * 256 + e);
      float gf[4];
      unpack4(gr, gf);
      f32x4 o;
#pragma unroll
      for (int q = 0; q < 4; ++q) o[q] = (acc[es][qs][q] - mu) * rstd * gv[q] * gf[q];
      *(u32x2*)(P_yret(p) + (long)qtok * 1024 + h * 256 + e) = pack4(o);
    }
  }
  __syncthreads();
}

__device__ __forceinline__ void phase_retout(const Params& p, int l, int g, char* lds, int bid, int nb) {
  const int n = g_smp_nb(g) * 128 + g_ctx_nb(g) * 16;
  for (int u = bid; u < n; u += nb) retout_unit(p, l, g, u, lds);
}

__device__ __forceinline__ void phase_gate(const Params& p, int l, char* lds, int bid, int nb) {
  const int tid = opaque_tid(), wid = tid >> 6, lane = tid & 63, fr = lane & 15, fq = lane >> 4;
  const int wn = wid >> 1, wm = wid & 1;
  const int MT = TG / 256, NT = 16;
  for (int tile = bid; tile < MT * NT; tile += nb) {
    const int mt = tile % MT, ntl = tile / MT, m0 = mt * 256, n0 = ntl * 128;
    f32x4 acc[4][8];
    zero_acc8(acc);
    gemm_kloop8(acc, P_hm(p) + (long)m0 * 1024, 1024, P_wt_g(p) + l * WTG_SZ + (long)n0 * 1024, 1024, 1024, lds);
#pragma unroll
    for (int j = 0; j < 8; ++j) {
      const int tl = m0 + wm * 128 + j * 16 + fr;
#pragma unroll
      for (int i = 0; i < 4; ++i) {
        const int n = n0 + wn * 64 + i * 16 + fq * 4;
        f32x4 s;
#pragma unroll
        for (int q = 0; q < 4; ++q) s[q] = sigmf(acc[i][j][q]);
        *(u32x2*)(P_gbuf(p) + (long)tl * 2048 + n) = pack4(s);
      }
    }
  }
}

__device__ __forceinline__ void phase_mixout(const Params& p, int l, int g, char* lds, int bid, int nb) {
  constexpr int NJ = 6;
  const int tid = opaque_tid(), wid = tid >> 6, lane = tid & 63, fr = lane & 15, fq = lane >> 4;
  const int wn = wid >> 1, wm = wid & 1;
  const int MT = TG / (NJ * 32), NT = 8;
  for (int tile = bid; tile < MT * NT; tile += nb) {
    const int mt = tile % MT, ntl = tile / MT, m0 = mt * (NJ * 32), n0 = ntl * 128;
    f32x4 acc[4][NJ];
    zero_accN<NJ>(acc);
    gemm_kloopN<NJ>(acc, P_yret(p) + (long)m0 * 1024, 1024, P_wt_ret(p) + l * WTR_SZ + (long)n0 * 1024, 1024, 1024, lds);
#pragma unroll
    for (int j = 0; j < NJ; ++j) {
      const int tl = m0 + wm * (NJ * 16) + j * 16 + fr;
#pragma unroll
      for (int i = 0; i < 4; ++i) {
        const int n = n0 + wn * 64 + i * 16 + fq * 4;
        float a[4], b[4];
        unpack4(*(const u32x2*)(P_gbuf(p) + (long)tl * 2048 + n), a);
        unpack4(*(const u32x2*)(P_gbuf(p) + (long)tl * 2048 + 1024 + n), b);
#pragma unroll
        for (int q = 0; q < 4; ++q) acc[i][j][q] = acc[i][j][q] * a[q] / b[q];
      }
      __builtin_amdgcn_sched_barrier(0);
    }
    gemm_kloopN<NJ>(acc, P_yna(p) + (long)m0 * 512, 512, P_wt_na(p) + l * WTN_SZ + (long)n0 * 512, 512, 512, lds);
#pragma unroll
    for (int j = 0; j < NJ; ++j) {
      const int tl = m0 + wm * (NJ * 16) + j * 16 + fr;
#pragma unroll
      for (int i = 0; i < 4; ++i) {
        const int n = n0 + wn * 64 + i * 16 + fq * 4;
        float b[4];
        unpack4(*(const u32x2*)(P_gbuf(p) + (long)tl * 2048 + 1024 + n), b);
        f32x4 o;
#pragma unroll
        for (int q = 0; q < 4; ++q) o[q] = acc[i][j][q] * b[q];
        *(u32x2*)(P_mbuf(p) + (long)tl * 1024 + n) = pack4(o);
      }
      __builtin_amdgcn_sched_barrier(0);
    }
  }
}

__device__ __forceinline__ void phase_gemm_f32(const u16* X, int K, const u16* W, u16* out, char* lds, int bid, int nb) {
  constexpr int NJ = 6;
  const int tid = opaque_tid(), wid = tid >> 6, lane = tid & 63, fr = lane & 15, fq = lane >> 4;
  const int wn = wid >> 1, wm = wid & 1;
  const int MT = TG / (NJ * 32), NT = 8;
  for (int tile = bid; tile < MT * NT; tile += nb) {
    const int mt = tile % MT, ntl = tile / MT, m0 = mt * (NJ * 32), n0 = ntl * 128;
    f32x4 acc[4][NJ];
    zero_accN<NJ>(acc);
    gemm_kloopN<NJ>(acc, X + (long)m0 * K, K, W + (long)n0 * K, K, K, lds);
#pragma unroll
    for (int j = 0; j < NJ; ++j) {
      const int tl = m0 + wm * (NJ * 16) + j * 16 + fr;
#pragma unroll
      for (int i = 0; i < 4; ++i) {
        const int n = n0 + wn * 64 + i * 16 + fq * 4;
        *(u32x2*)(out + (long)tl * 1024 + n) = pack4(acc[i][j]);
      }
    }
  }
}

__device__ __forceinline__ void phase_ffn_up(const Params& p, int l, char* lds, int bid, int nb) {
  const int tid = opaque_tid(), wid = tid >> 6, lane = tid & 63, fr = lane & 15, fq = lane >> 4;
  const int wn = wid >> 1, wm = wid & 1;
  constexpr int NJ = 6;
  const int MT = TG / (NJ * 32), NT = 5632 / 128;
  const u16* W = P_wt_gu(p) + l * WTGU_SZ;
  for (int tile = bid; tile < MT * NT; tile += nb) {
    const int mt = tile % MT, ntl = tile / MT, m0 = mt * (NJ * 32), n0 = ntl * 128;
    f32x4 acc[4][NJ];
    zero_accN<NJ>(acc);
    gemm_kloopN<NJ>(acc, P_hm(p) + (long)m0 * 1024, 1024, W + (long)n0 * 1024, 1024, 1024, lds);
    const int ffb = ((n0 + wn * 64) >> 6) * 32;
#pragma unroll
    for (int j = 0; j < NJ; ++j) {
      const int tl = m0 + wm * (NJ * 16) + j * 16 + fr;
#pragma unroll
      for (int i = 0; i < 2; ++i) {
        f32x4 o;
#pragma unroll
        for (int q = 0; q < 4; ++q) o[q] = siluf(acc[i][j][q]) * acc[i + 2][j][q];
        *(u32x2*)(P_ubuf(p) + (long)tl * DFF + ffb + i * 16 + fq * 4) = pack4(o);
      }
    }
  }
}


#define XB_TMO      128
#define XB_XCNT(j)  (256  + 64 * (j))
#define XB_XSUB(j)  (1280 + 64 * (j))
#define XB_XGEN(j)  (2304 + 64 * (j))
#define XB_TOP      3328
#define XB_TOPGEN   3392
#define XCD_BAR_WORDS 3456
#define XB_SPIN_CAP (1u << 22)
#define LAS __attribute__((address_space(3)))
__device__ __forceinline__ unsigned xb_ld(unsigned* p)              { return __hip_atomic_load(p, __ATOMIC_RELAXED, __HIP_MEMORY_SCOPE_AGENT); }
__device__ __forceinline__ unsigned xb_add(unsigned* p, unsigned v) { return __hip_atomic_fetch_add(p, v, __ATOMIC_RELAXED, __HIP_MEMORY_SCOPE_AGENT); }
__device__ __forceinline__ unsigned xb_xcc_id() { return (unsigned)__builtin_amdgcn_s_getreg((3 << 11) | 20) & 0xFu; }
#define XB_SPIN(cond, bar) do { unsigned _sp = 0; while (cond) { __builtin_amdgcn_s_sleep(1); \
    if ((++_sp & 255u) == 0u) { if (xb_ld(&(bar)[XB_TMO])) break; if (_sp > XB_SPIN_CAP) { atomicAdd(&(bar)[XB_TMO], 1u); break; } } } } while (0)
struct XcdBarrier { unsigned* bar; unsigned x; volatile LAS unsigned* st; };
__device__ __forceinline__ XcdBarrier xcd_barrier_post(unsigned* bar, volatile LAS unsigned* st) {
    XcdBarrier b; b.bar = bar; b.x = xb_xcc_id(); b.st = st;
    if (threadIdx.x == 0) (void)xb_add(&bar[XB_XCNT(b.x)], 1u);
    return b;
}
__device__ __forceinline__ void xcd_barrier_complete(unsigned* bar, unsigned x, unsigned& nloc, unsigned& nx) {
    const unsigned G = gridDim.x * gridDim.y * gridDim.z;
    unsigned sum, cnt, mine, sp = 0u;
    for (;;) {
        sum = 0u; cnt = 0u; mine = 0u;
#pragma unroll
        for (unsigned j = 0; j < 16; ++j) { const unsigned c = xb_ld(&bar[XB_XCNT(j)]); sum += c; cnt += (c > 0u) ? 1u : 0u; mine = (j == x) ? c : mine; }
        if (sum == G) break;
        __builtin_amdgcn_s_sleep(1);
        if ((++sp & 255u) == 0u) { if (xb_ld(&bar[XB_TMO])) break; if (sp > XB_SPIN_CAP) { atomicAdd(&bar[XB_TMO], 1u); break; } }
    }
    nloc = mine > 0u ? mine : 1u; nx = cnt > 0u ? cnt : 1u;
}
__device__ __forceinline__ void xcd_barrier(const XcdBarrier& b) {
    asm volatile("s_waitcnt vmcnt(0)" ::: "memory");
    __syncthreads();
    if (threadIdx.x == 0) {
        unsigned* bar = b.bar;
        __builtin_amdgcn_s_waitcnt(0);
        unsigned nloc = b.st[0], nx = b.st[1];
        if (nloc == 0u) { xcd_barrier_complete(bar, b.x, nloc, nx); b.st[0] = nloc; b.st[1] = nx; }
        const unsigned old = xb_add(&bar[XB_XSUB(b.x)], 1u);
        const unsigned gen = old / nloc;
        if (old + 1u == (gen + 1u) * nloc) {
            __builtin_amdgcn_fence(__ATOMIC_RELEASE, "agent");
            asm volatile("s_waitcnt vmcnt(0)" ::: "memory");
            const unsigned og = xb_add(&bar[XB_TOP], 1u);
            const unsigned tg = og / nx;
            if (og + 1u == (tg + 1u) * nx) xb_add(&bar[XB_TOPGEN], 1u);
            else XB_SPIN(xb_ld(&bar[XB_TOPGEN]) == tg, bar);
            __builtin_amdgcn_fence(__ATOMIC_ACQUIRE, "agent");
            xb_add(&bar[XB_XGEN(b.x)], 1u);
            asm volatile("s_waitcnt vmcnt(0)" ::: "memory");
        } else {
            XB_SPIN(xb_ld(&bar[XB_XGEN(b.x)]) == gen, bar);
            __builtin_amdgcn_fence(__ATOMIC_ACQUIRE, "agent");
            asm volatile("s_waitcnt vmcnt(0)" ::: "memory");
        }
    }
    __syncthreads();
}

__device__ __forceinline__ void run_step(const Params& pin, int s, char* lds, int bid, int nb) {
  Params p = pin;
  { size_t z_ = 0; asm volatile("" : "+s"(z_)); p.ws = pin.ws + z_; p.out = pin.out + z_; }
  if (s == 0) { for (int rep_ = 0; rep_ < ((DUPMASK & 0x200) ? 2 : 1); ++rep_) phase0(p, lds, bid, nb); return; }
  if (s == 1) { phase_hm(p, 0, 0, bid, nb); return; }
  const int idx = s - 2, lg = idx / 10, ph = idx % 10, l = lg / NG, g = lg % NG;
#define REP(bit) for (int rep_ = 0; rep_ < ((DUPMASK & (bit)) ? 2 : 1); ++rep_)
  switch (ph) {
    case 0: phase_proj(p, l, g, lds, 4 * (TG / 256) + bid, (TG / 256) * 36, nb); break;
    case 1: phase_mix_a(p, l, g, lds, P_bar(p) + XCD_BAR_WORDS + 4 * s, bid * 2 >= nb); break;
    case 2: phase_prefix(p, l, g, bid, nb); break;
    case 3: {
      const int n_ret = g_smp_nb(g) * 128 + g_ctx_nb(g) * 16;
      const int u0 = bid >= n_ret ? bid : bid + ((n_ret - bid + nb - 1) / nb) * nb;
      if (bid * 2 >= nb) phase_gate(p, l, lds, u0 - n_ret, nb);
      phase_retout(p, l, g, lds, bid, nb);
      if (bid * 2 < nb) phase_gate(p, l, lds, u0 - n_ret, nb);
    } break;
    case 4: REP(8) phase_mixout(p, l, g, lds, bid, nb); break;
    case 5: REP(16) phase_gemm_f32(P_mbuf(p), 1024, P_wt_o(p) + l * WTO_SZ, P_mixed(p), lds, bid, nb); break;
    case 6: phase_post_mix(p, l, g, bid, nb); break;
    case 7: REP(64) phase_ffn_up(p, l, lds, bid, nb); break;
    case 8: REP(128) phase_gemm_f32(P_ubuf(p), DFF, P_wt_dn(p) + l * WTD_SZ, P_mixed(p), lds, bid, nb); break;
    default: {
      phase_post_ffn(p, l, g, bid, nb);
      const int g2 = g + 1 < NG ? g + 1 : 0, l2 = g + 1 < NG ? l : l + 1;
      if (l2 < 2) phase_hm(p, l2, g2, bid, nb);
    } break;
  }
}
#define NSTEPS (2 + 2 * NG * 10)
__global__ void __launch_bounds__(NTHREADS, 2) mega(Params p) {
  __shared__ __attribute__((aligned(1024))) char lds[65536];
  __shared__ uint4 xb_words;
  cg::grid_group grid = cg::this_grid();
  const int bid = blockIdx.x, nb = gridDim.x;
  if (threadIdx.x == 0) xb_words = make_uint4(0u, 0u, 0u, 0u);
  __syncthreads();
  XcdBarrier xb = xcd_barrier_post(P_bar(p), (volatile LAS unsigned*)&xb_words);
#pragma nounroll
  for (int s = 0; s < NSTEPS; ++s) {
    run_step(p, s, lds, bid, nb);
    if (s + 1 < NSTEPS) {
      if (s == 0) grid.sync();
      else xcd_barrier(xb);
    }
  }
}

extern "C" void kernel_launch(void* const* d_in, const int* in_sizes, int n_in, void* d_out, int out_size, void* d_ws,
                              size_t ws_size, hipStream_t stream) {
  static int grid_blocks = 0;
  if (!grid_blocks) {
    int dev = 0, cus = 0, per_cu = 0;
    (void)hipGetDevice(&dev);
    (void)hipDeviceGetAttribute(&cus, hipDeviceAttributeMultiprocessorCount, dev);
    (void)hipOccupancyMaxActiveBlocksPerMultiprocessor(&per_cu, (const void*)mega, NTHREADS, 0);
    if (per_cu > 2) per_cu = 2;
    grid_blocks = cus * per_cu;
    if (grid_blocks <= 0) { fprintf(stderr, "occupancy query failed (cus %d per_cu %d)\n", cus, per_cu); grid_blocks = -1; }
  }
  if (grid_blocks < 0) return;
  Params p{};
  const float* const* in = (const float* const*)d_in;
  p.x_prompt = in[0]; p.x_sample = in[1]; p.cache_k = in[2]; p.cache_v = in[3]; p.state_ret = in[4]; p.c = in[5]; p.c_ctx = in[6];
  p.w_ada = in[7]; p.b_ada = in[8]; p.n_pre_mix = in[9]; p.n_post_mix = in[10]; p.n_pre_ffn = in[11]; p.n_post_ffn = in[12];
  p.w_in = in[13]; p.decay_logit = in[14]; p.gn_gain = in[15]; p.rpb = in[16]; p.w_ret_out = in[17]; p.w_na_out = in[18];
  p.w_gate = in[19]; p.w_o = in[20]; p.w_ffn_gate = in[21]; p.w_ffn_up = in[22]; p.w_ffn_down = in[23];
  p.out = (float*)d_out;
  p.ws = (char*)d_ws;
  if (WS_TOTAL > ws_size) { fprintf(stderr, "workspace too small: need %zu have %zu\n", (size_t)WS_TOTAL, ws_size); return; }
  if (hipMemsetAsync(p.ws + OFF_bar, 0, (XCD_BAR_WORDS + 256) * 4, stream) != hipSuccess) { fprintf(stderr, "memset failed\n"); return; }
  void* args[] = {&p};
  hipError_t e = hipLaunchCooperativeKernel((void*)mega, dim3(grid_blocks), dim3(NTHREADS), args, 0, stream);
  if (e != hipSuccess) fprintf(stderr, "cooperative launch failed: %s (grid %d)\n", hipGetErrorString(e), grid_blocks);
}
```

```cpp
#include <hip/hip_runtime.h>
#include <hip/hip_cooperative_groups.h>
#include <cstdio>
namespace cg = cooperative_groups;

typedef unsigned short u16;
using bf16x8 = __attribute__((ext_vector_type(8))) short;
using f32x4 = __attribute__((ext_vector_type(4))) float;
using i32x4 = __attribute__((ext_vector_type(4))) int;
using u32x2 = __attribute__((ext_vector_type(2))) unsigned;

#ifndef DUPMASK
#define DUPMASK 0
#endif
#define NTHREADS 256
#define NG 2
#define TG 12288
#define DM 1024
#define DFF 2816
#define EPSV 1e-6f

__host__ __device__ constexpr int g_ctx_nb(int g) { return g == 0 ? 32 : 0; }
__host__ __device__ constexpr int g_smp_b0(int g) { return g == 0 ? 0 : 2; }
__host__ __device__ constexpr int g_smp_nb(int g) { return g == 0 ? 2 : 6; }

struct Params {
  const float *x_prompt, *x_sample, *cache_k, *cache_v, *state_ret, *c, *c_ctx, *w_ada, *b_ada;
  const float *n_pre_mix, *n_post_mix, *n_pre_ffn, *n_post_ffn, *w_in, *decay_logit, *gn_gain, *rpb;
  const float *w_ret_out, *w_na_out, *w_gate, *w_o, *w_ffn_gate, *w_ffn_up, *w_ffn_down;
  float* out;
  char* ws;
};


#define OUT_YP 0L
#define OUT_YS 8388608L
#define OUT_NK 25165824L
#define OUT_NV 33554432L
#define OUT_ST 41943040L

__device__ __forceinline__ int opaque_tid() { int t = threadIdx.x; asm volatile("" : "+v"(t)); return t; }
typedef __bf16 bf16x2_t __attribute__((ext_vector_type(2)));
typedef float f32x2_t __attribute__((ext_vector_type(2)));
__device__ __forceinline__ unsigned pk2(float a, float b) {
  f32x2_t v = {a, b};
  bf16x2_t r = __builtin_convertvector(v, bf16x2_t);
  return __builtin_bit_cast(unsigned, r);
}
__device__ __forceinline__ u16 f2bf(float f) { return (u16)(pk2(f, 0.f) & 0xffffu); }
__device__ __forceinline__ float bf2f(u16 h) { return __uint_as_float(((unsigned)h) << 16); }
__device__ __forceinline__ u32x2 pack4(f32x4 v) { u32x2 r; r.x = pk2(v[0], v[1]); r.y = pk2(v[2], v[3]); return r; }
__device__ __forceinline__ void unpack4(u32x2 v, float (&o)[4]) {
  o[0] = bf2f((u16)(v.x & 0xffff)); o[1] = bf2f((u16)(v.x >> 16)); o[2] = bf2f((u16)(v.y & 0xffff)); o[3] = bf2f((u16)(v.y >> 16));
}
__device__ __forceinline__ f32x4 unpack4v(u32x2 v) {
  f32x4 o; o[0] = bf2f((u16)(v.x & 0xffff)); o[1] = bf2f((u16)(v.x >> 16)); o[2] = bf2f((u16)(v.y & 0xffff)); o[3] = bf2f((u16)(v.y >> 16)); return o;
}
__device__ __forceinline__ float shfl_xor_l(float v, int mask, int lane) {
  return __int_as_float(__builtin_amdgcn_ds_bpermute((lane ^ mask) << 2, __float_as_int(v)));
}
__device__ __forceinline__ float wave_sum(float v) {
  const int lane = opaque_tid() & 63;
#pragma unroll
  for (int o = 1; o < 64; o <<= 1) v += shfl_xor_l(v, o, lane);
  return v;
}
__device__ __forceinline__ float siluf(float x) { return x / (1.f + __expf(-x)); }
__device__ __forceinline__ float sigmf(float x) { return 1.f / (1.f + __expf(-x)); }
__device__ __forceinline__ float log_sigmoid(float x) { return fminf(x, 0.f) - log1pf(expf(-fabsf(x))); }

__device__ __forceinline__ int tperm32(int k) { return ((k & 15) >> 2) * 8 + (k >> 4) * 4 + (k & 3); }
__device__ __forceinline__ int tcol_of(int t) { return (t & ~31) | tperm32(t & 31); }
__device__ __forceinline__ int gtok_of(int g, int t) {
  const int nc = g_ctx_nb(g) * 256;
  return t < nc ? t : 8192 + g_smp_b0(g) * 2048 + (t - nc);
}
__device__ __forceinline__ int modidx_of(int g, int t) {
  const int nc = g_ctx_nb(g) * 256;
  return t < nc ? 0 : 1 + g_smp_b0(g) + (t - nc) / 2048;
}

__device__ __forceinline__ int lds_byte(int r, int c) {
  int st = (r >> 4) * 2 + (c >> 5), ob = (r & 15) * 64 + (c & 31) * 2;
  return st * 1024 + (ob ^ (((ob >> 9) & 1) << 5));
}

__device__ __forceinline__ void gemm_kloop(f32x4 (&acc)[4][4], const u16* X, int ldx, const u16* W, int ldw, int K, char* lds) {
  const int tid = opaque_tid(), wid = tid >> 6, lane = tid & 63;
  const int fr = lane & 15, fq = lane >> 4;
  const int wn = wid >> 1, wm = wid & 1;
  const int sb = lane * 16;
  const int swz = sb ^ (((sb >> 9) & 1) << 5);
  const int rbase = (wid >> 1) * 16 + (swz >> 6);
  const int cc = (wid & 1) * 32 + ((swz & 63) >> 1);
  const u16* xs = X + (long)rbase * ldx + cc;
  const u16* wsrc = W + (long)rbase * ldw + cc;
  const int soff = wid * 1024 + lane * 16;
  i32x4 sx[4], sw[4];
  const int nt = K >> 6;
#define G_ISSUE(kt_)                                                        \
  _Pragma("unroll") for (int i = 0; i < 4; ++i) {                           \
    sx[i] = *(const i32x4*)(xs + (long)(32 * i) * ldx + (kt_) * 64);        \
    sw[i] = *(const i32x4*)(wsrc + (long)(32 * i) * ldw + (kt_) * 64);      \
  }
#define G_WRITE(b_)                                                         \
  _Pragma("unroll") for (int i = 0; i < 4; ++i) {                           \
    *(i32x4*)(lds + (b_) * 32768 + soff + i * 4096) = sx[i];                \
    *(i32x4*)(lds + (b_) * 32768 + 16384 + soff + i * 4096) = sw[i];        \
  }
  G_ISSUE(0);
  G_WRITE(0);
  if (nt > 1) { G_ISSUE(1); }
  __syncthreads();
  for (int t = 0; t < nt; ++t) {
    const int cur = t & 1;
    if (t + 1 < nt) { G_WRITE(cur ^ 1); }
    if (t + 2 < nt) { G_ISSUE(t + 2); }
    const char* sX = lds + cur * 32768;
    const char* sW = sX + 16384;
#pragma unroll
    for (int ks = 0; ks < 2; ++ks) {
      bf16x8 wf[4], xf[4];
#pragma unroll
      for (int i = 0; i < 4; ++i) wf[i] = *(const bf16x8*)(sW + lds_byte(wn * 64 + i * 16 + fr, ks * 32 + fq * 8));
#pragma unroll
      for (int j = 0; j < 4; ++j) xf[j] = *(const bf16x8*)(sX + lds_byte(wm * 64 + j * 16 + fr, ks * 32 + fq * 8));
#pragma unroll
      for (int i = 0; i < 4; ++i)
#pragma unroll
        for (int j = 0; j < 4; ++j) acc[i][j] = __builtin_amdgcn_mfma_f32_16x16x32_bf16(wf[i], xf[j], acc[i][j], 0, 0, 0);
    }
    __syncthreads();
  }
#undef G_ISSUE
#undef G_WRITE
}

__device__ __forceinline__ void zero_acc(f32x4 (&acc)[4][4]) {
#pragma unroll
  for (int i = 0; i < 4; ++i)
#pragma unroll
    for (int j = 0; j < 4; ++j) acc[i][j] = f32x4{0.f, 0.f, 0.f, 0.f};
}


__device__ __forceinline__ int lds_byte32(int r, int c) {
  int ob = (r & 15) * 64 + c * 2;
  return (r >> 4) * 1024 + (ob ^ (((ob >> 9) & 1) << 5));
}
template <int NJ>
__device__ __forceinline__ void gemm_kloopN(f32x4 (&acc)[4][NJ], const u16* X, int ldx, const u16* W, int ldw, int K, char* lds) {
  constexpr int NXL = NJ / 2;
  constexpr int JH = NJ / 2;
  const int tid = opaque_tid(), wid = tid >> 6, lane = tid & 63;
  const int fr = lane & 15, fq = lane >> 4;
  const int wn = wid >> 1, wm = wid & 1;
  const int sb = lane * 16;
  const int swz = sb ^ (((sb >> 9) & 1) << 5);
  const int rr = swz >> 6, cc = (swz & 63) >> 1;
  const u16* xs = X + (long)(wid * NXL * 16 + rr) * ldx + cc;
  const u16* wsrc = W + (long)(wid * 32 + rr) * ldw + cc;
  const int soff = lane * 16;
  i32x4 sx[NXL], sw[2];
  const int nt = K >> 5;
#define G8_ISSUE(kt_)                                                                         \
  _Pragma("unroll") for (int i = 0; i < NXL; ++i) sx[i] = *(const i32x4*)(xs + (long)(16 * i) * ldx + (kt_) * 32); \
  _Pragma("unroll") for (int i = 0; i < 2; ++i) sw[i] = *(const i32x4*)(wsrc + (long)(16 * i) * ldw + (kt_) * 32);
#define G8_WRITE(b_)                                                                          \
  _Pragma("unroll") for (int i = 0; i < NXL; ++i) *(i32x4*)(lds + (b_) * 24576 + (wid * NXL + i) * 1024 + soff) = sx[i]; \
  _Pragma("unroll") for (int i = 0; i < 2; ++i) *(i32x4*)(lds + (b_) * 24576 + 16384 + (wid * 2 + i) * 1024 + soff) = sw[i];
  G8_ISSUE(0);
  G8_WRITE(0);
  if (nt > 1) { G8_ISSUE(1); }
  __syncthreads();
  for (int t = 0; t < nt; ++t) {
    const int cur = t & 1;
    if (t + 1 < nt) { G8_WRITE(cur ^ 1); }
    if (t + 2 < nt) { G8_ISSUE(t + 2); }
    const char* sX = lds + cur * 24576;
    const char* sW = sX + 16384;
    bf16x8 wf[4];
#pragma unroll
    for (int i = 0; i < 4; ++i) wf[i] = *(const bf16x8*)(sW + lds_byte32(wn * 64 + i * 16 + fr, fq * 8));
#pragma unroll
    for (int jh = 0; jh < 2; ++jh) {
      bf16x8 xf[JH];
#pragma unroll
      for (int j = 0; j < JH; ++j) xf[j] = *(const bf16x8*)(sX + lds_byte32(wm * (NJ * 16) + (jh * JH + j) * 16 + fr, fq * 8));
#pragma unroll
      for (int i = 0; i < 4; ++i)
#pragma unroll
        for (int j = 0; j < JH; ++j) acc[i][jh * JH + j] = __builtin_amdgcn_mfma_f32_16x16x32_bf16(wf[i], xf[j], acc[i][jh * JH + j], 0, 0, 0);
      __builtin_amdgcn_sched_barrier(0);
    }
    __syncthreads();
  }
#undef G8_ISSUE
#undef G8_WRITE
}
__device__ __forceinline__ void gemm_kloop8(f32x4 (&acc)[4][8], const u16* X, int ldx, const u16* W, int ldw, int K, char* lds) {
  gemm_kloopN<8>(acc, X, ldx, W, ldw, K, lds);
}
template <int NJ>
__device__ __forceinline__ void zero_accN(f32x4 (&acc)[4][NJ]) {
#pragma unroll
  for (int i = 0; i < 4; ++i)
#pragma unroll
    for (int j = 0; j < NJ; ++j) acc[i][j] = f32x4{0.f, 0.f, 0.f, 0.f};
}
__device__ __forceinline__ void zero_acc8(f32x4 (&acc)[4][8]) {
#pragma unroll
  for (int i = 0; i < 4; ++i)
#pragma unroll
    for (int j = 0; j < 8; ++j) acc[i][j] = f32x4{0.f, 0.f, 0.f, 0.f};
}

__device__ __forceinline__ void tr_job(const float* srcA, int ldA, const float* srcB, int ldB, u16* dst, int ldd, char* lds, bool permk = false) {
  u16(*tile)[72] = (u16(*)[72])lds;
  const int t = opaque_tid(), colj = t & 31, half = (t >> 5) & 1, kr = t >> 6;
  const float* s = half ? srcB : srcA;
  const int ld = half ? ldB : ldA;
#pragma unroll
  for (int i = 0; i < 16; ++i) {
    int kk = i * 4 + kr;
    const int kw = permk ? ((kk & 32) | tperm32(kk & 31)) : kk;
    tile[half * 32 + colj][kw] = f2bf(s[(long)kk * ld + colj]);
  }
  __syncthreads();
  const int n = t >> 2, ks = (t & 3) * 16;
  i32x4 a = *(const i32x4*)&tile[n][ks], b = *(const i32x4*)&tile[n][ks + 8];
  *(i32x4*)(dst + (long)n * ldd + ks) = a;
  *(i32x4*)(dst + (long)n * ldd + ks + 8) = b;
  __syncthreads();
}

#define WT1_SZ (4608L * 1024)
#define WTG_SZ (2048L * 1024)
#define WTR_SZ (1024L * 1024)
#define WTN_SZ (1024L * 512)
#define WTO_SZ (1024L * 1024)
#define WTGU_SZ (5632L * 1024)
#define WTD_SZ (1024L * 2816)

constexpr size_t al256(size_t x) { return (x + 255) & ~(size_t)255; }
constexpr size_t OFF_wt1 = 0;
constexpr size_t OFF_wt_g = OFF_wt1 + al256(2 * WT1_SZ * 2);
constexpr size_t OFF_wt_ret = OFF_wt_g + al256(2 * WTG_SZ * 2);
constexpr size_t OFF_wt_na = OFF_wt_ret + al256(2 * WTR_SZ * 2);
constexpr size_t OFF_wt_o = OFF_wt_na + al256(2 * WTN_SZ * 2);
constexpr size_t OFF_wt_gu = OFF_wt_o + al256(2 * WTO_SZ * 2);
constexpr size_t OFF_wt_dn = OFF_wt_gu + al256(2 * WTGU_SZ * 2);
constexpr size_t OFF_bar = OFF_wt_dn + al256(2 * WTD_SZ * 2);
constexpr size_t OFF_mod = OFF_bar + al256((3456 + 256) * 4);
constexpr size_t OFF_ropetab = OFF_mod + al256(2 * 9 * 6144 * 4);
constexpr size_t OFF_ckb = OFF_ropetab + al256(4096 * 4);
constexpr size_t OFF_cvt = OFF_ckb + al256(4194304L * 2);
constexpr size_t OFF_hm = OFF_cvt + al256(4194304L * 2);
constexpr size_t OFF_rq = OFF_hm + al256((size_t)TG * 1024 * 2);
constexpr size_t OFF_rk = OFF_rq + al256((size_t)TG * 512 * 2);
constexpr size_t OFF_vt = OFF_rk + al256((size_t)TG * 512 * 2);
constexpr size_t OFF_rg = OFF_vt + al256((size_t)TG * 1024 * 2);
constexpr size_t OFF_nq = OFF_rg + al256((size_t)TG * 1024 * 2);
constexpr size_t OFF_nk = OFF_nq + al256((size_t)TG * 512 * 2);
constexpr size_t OFF_nvt = OFF_nk + al256((size_t)TG * 512 * 2);
constexpr size_t OFF_kt = OFF_nvt + al256((size_t)TG * 512 * 2);
constexpr size_t OFF_ktb = OFF_kt + al256((size_t)TG * 512 * 2);
constexpr size_t OFF_St = OFF_ktb + al256((size_t)TG * 512 * 2);
constexpr size_t OFF_yret = OFF_St + al256((size_t)768 * 65536);
constexpr size_t OFF_yna = OFF_yret + al256((size_t)TG * 1024 * 2);
constexpr size_t WS_TOTAL = OFF_yna + al256((size_t)TG * 512 * 2);
constexpr size_t OFF_mbuf = OFF_rq;
constexpr size_t OFF_mixed = OFF_vt;
constexpr size_t OFF_ubuf = OFF_St;
constexpr size_t OFF_gbuf = OFF_nq;
#define P_wt1(p) ((u16*)((p).ws + OFF_wt1))
#define P_wt_g(p) ((u16*)((p).ws + OFF_wt_g))
#define P_wt_ret(p) ((u16*)((p).ws + OFF_wt_ret))
#define P_wt_na(p) ((u16*)((p).ws + OFF_wt_na))
#define P_wt_o(p) ((u16*)((p).ws + OFF_wt_o))
#define P_wt_gu(p) ((u16*)((p).ws + OFF_wt_gu))
#define P_wt_dn(p) ((u16*)((p).ws + OFF_wt_dn))
#define P_ckb(p) ((u16*)((p).ws + OFF_ckb))
#define P_cvt(p) ((u16*)((p).ws + OFF_cvt))
#define P_hm(p) ((u16*)((p).ws + OFF_hm))
#define P_rq(p) ((u16*)((p).ws + OFF_rq))
#define P_rk(p) ((u16*)((p).ws + OFF_rk))
#define P_kt(p) ((u16*)((p).ws + OFF_kt))
#define P_ktb(p) ((u16*)((p).ws + OFF_ktb))
#define P_vt(p) ((u16*)((p).ws + OFF_vt))
#define P_rg(p) ((u16*)((p).ws + OFF_rg))
#define P_nq(p) ((u16*)((p).ws + OFF_nq))
#define P_nk(p) ((u16*)((p).ws + OFF_nk))
#define P_nvt(p) ((u16*)((p).ws + OFF_nvt))
#define P_St(p) ((u16*)((p).ws + OFF_St))
#define P_yret(p) ((u16*)((p).ws + OFF_yret))
#define P_yna(p) ((u16*)((p).ws + OFF_yna))
#define P_mbuf(p) ((u16*)((p).ws + OFF_mbuf))
#define P_ubuf(p) ((u16*)((p).ws + OFF_ubuf))
#define P_gbuf(p) ((u16*)((p).ws + OFF_gbuf))
#define P_mod(p) ((float*)((p).ws + OFF_mod))
#define P_ropetab(p) ((float*)((p).ws + OFF_ropetab))
#define P_mixed(p) ((u16*)((p).ws + OFF_mixed))
#define P_bar(p) ((unsigned*)((p).ws + OFF_bar))

struct TrJob { const float* sA; int ldA; const float* sB; int ldB; u16* dst; int ldd; int permk; };
__device__ __forceinline__ TrJob tr_decode(const Params& p, int j) {
  const int JL = 1152 + 512 + 256 + 128 + 256 + 1408 + 704;
    if (j < 2 * JL) {
      const int l = j / JL;
      int r = j % JL;
      if (r < 1152) {
        int nt = r / 16, kt = r % 16, n0 = nt * 64, k0 = kt * 64, cA, cB;
        if (n0 < 1024) { int h8 = n0 / 128, blk = (n0 % 128) / 64; cA = h8 * 128 + blk * 32; cB = cA + 64; }
        else { cA = n0; cB = n0 + 32; }
        const float* src = p.w_in + (long)l * 1024 * 4608 + (long)k0 * 4608;
        return TrJob{src + cA, 4608, src + cB, 4608, P_wt1(p) + l * WT1_SZ + (long)n0 * 1024 + k0, 1024, 0};
      }
      r -= 1152;
      if (r < 512) {
        int nt = r / 16, kt = r % 16, n0 = nt * 64, k0 = kt * 64;
        const float* src = p.w_gate + (long)l * 1024 * 2048 + (long)k0 * 2048 + n0;
        return TrJob{src, 2048, src + 32, 2048, P_wt_g(p) + l * WTG_SZ + (long)n0 * 1024 + k0, 1024, 0};
      }
      r -= 512;
      if (r < 256) {
        int nt = r / 16, kt = r % 16, n0 = nt * 64, k0 = kt * 64;
        const float* src = p.w_ret_out + (long)l * 1024 * 1024 + (long)k0 * 1024 + n0;
        return TrJob{src, 1024, src + 32, 1024, P_wt_ret(p) + l * WTR_SZ + (long)n0 * 1024 + k0, 1024, 0};
      }
      r -= 256;
      if (r < 128) {
        int nt = r / 8, kt = r % 8, n0 = nt * 64, k0 = kt * 64;
        const float* src = p.w_na_out + (long)l * 512 * 1024 + (long)k0 * 1024 + n0;
        return TrJob{src, 1024, src + 32, 1024, P_wt_na(p) + l * WTN_SZ + (long)n0 * 512 + k0, 512, 0};
      }
      r -= 128;
      if (r < 256) {
        int nt = r / 16, kt = r % 16, n0 = nt * 64, k0 = kt * 64;
        const float* src = p.w_o + (long)l * 1024 * 1024 + (long)k0 * 1024 + n0;
        return TrJob{src, 1024, src + 32, 1024, P_wt_o(p) + l * WTO_SZ + (long)n0 * 1024 + k0, 1024, 0};
      }
      r -= 256;
      if (r < 1408) {
        int nt = r / 16, kt = r % 16, n0 = nt * 64, k0 = kt * 64;
        const float* sg = p.w_ffn_gate + (long)l * 1024 * DFF + (long)k0 * DFF + nt * 32;
        const float* su = p.w_ffn_up + (long)l * 1024 * DFF + (long)k0 * DFF + nt * 32;
        return TrJob{sg, DFF, su, DFF, P_wt_gu(p) + l * WTGU_SZ + (long)n0 * 1024 + k0, 1024, 0};
      }
      r -= 1408;
      {
        int nt = r / 44, kt = r % 44, n0 = nt * 64, k0 = kt * 64;
        const float* src = p.w_ffn_down + (long)l * DFF * 1024 + (long)k0 * 1024 + n0;
        return TrJob{src, 1024, src + 32, 1024, P_wt_dn(p) + l * WTD_SZ + (long)n0 * DFF + k0, DFF, 0};
      }
    } else {
      int r = j - 2 * JL;
      int m = r / 64, q = r % 64, nt = q / 8, kt = q % 8, n0 = nt * 64, k0 = kt * 64;
      const float* src = p.cache_v + (long)m * 262144 + (long)k0 * 512 + n0;
      return TrJob{src, 512, src + 32, 512, P_cvt(p) + (long)m * 262144 + (long)n0 * 512 + k0, 512, 1};
    }
}
__device__ __forceinline__ void tr_load(const TrJob& jb, float (&r)[16]) {
  const int t = opaque_tid(), colj = t & 31, half = (t >> 5) & 1, kr = t >> 6;
  const float* s = half ? jb.sB : jb.sA;
  const int ld = half ? jb.ldB : jb.ldA;
#pragma unroll
  for (int i = 0; i < 16; ++i) r[i] = s[(long)(i * 4 + kr) * ld + colj];
}
__device__ __forceinline__ void tr_store(const TrJob& jb, const float (&r)[16], char* lds) {
  u16(*tile)[72] = (u16(*)[72])lds;
  const int t = opaque_tid(), colj = t & 31, half = (t >> 5) & 1, kr = t >> 6;
#pragma unroll
  for (int i = 0; i < 16; ++i) {
    const int kk = i * 4 + kr;
    const int kw = jb.permk ? ((kk & 32) | tperm32(kk & 31)) : kk;
    tile[half * 32 + colj][kw] = f2bf(r[i]);
  }
  __syncthreads();
  const int n = t >> 2, ks = (t & 3) * 16;
  i32x4 a = *(const i32x4*)&tile[n][ks], b = *(const i32x4*)&tile[n][ks + 8];
  *(i32x4*)(jb.dst + (long)n * jb.ldd + ks) = a;
  *(i32x4*)(jb.dst + (long)n * jb.ldd + ks + 8) = b;
  __syncthreads();
}
__device__ __forceinline__ void phase0(const Params& p, char* lds, int bid, int nb) {
  const int JL = 1152 + 512 + 256 + 128 + 256 + 1408 + 704;
  const int NJ = 2 * JL + 1024;
  {
    int j = bid;
    TrJob cur = tr_decode(p, j < NJ ? j : 0);
    float ra[16];
    if (j < NJ) tr_load(cur, ra);
    for (; j < NJ; j += nb) {
      const int jn = j + nb;
      TrJob nx = tr_decode(p, jn < NJ ? jn : 0);
      float rb[16];
      if (jn < NJ) tr_load(nx, rb);
      tr_store(cur, ra, lds);
      cur = nx;
#pragma unroll
      for (int i = 0; i < 16; ++i) ra[i] = rb[i];
    }
  }
  {
    float* sv = (float*)lds;
    float* part = (float*)(lds + 36864);
    const int t = opaque_tid();
    for (int j = nb - 1 - bid; j < 384; j += nb) {
      const int l = j / 192, n0 = (j % 192) * 32;
      for (int i = t; i < 9 * 1024; i += NTHREADS) {
        int v = i >> 10, k = i & 1023;
        float cv = v == 0 ? p.c_ctx[k] : p.c[(v - 1) * 1024 + k];
        sv[i] = cv / (1.f + expf(-cv));
      }
      __syncthreads();
      const int col = t & 31, kq = t >> 5;
      float a[9];
#pragma unroll
      for (int v = 0; v < 9; ++v) a[v] = 0.f;
      const float* w = p.w_ada + (long)l * 1024 * 6144 + (long)(kq * 128) * 6144 + n0 + col;
      for (int k0 = 0; k0 < 128; k0 += 16) {
        float wv[16];
#pragma unroll
        for (int kk = 0; kk < 16; ++kk) wv[kk] = w[(long)(k0 + kk) * 6144];
#pragma unroll
        for (int kk = 0; kk < 16; ++kk)
#pragma unroll
          for (int v = 0; v < 9; ++v) a[v] += sv[v * 1024 + kq * 128 + k0 + kk] * wv[kk];
      }
#pragma unroll
      for (int v = 0; v < 9; ++v) part[(kq * 9 + v) * 32 + col] = a[v];
      __syncthreads();
      for (int i = t; i < 9 * 32; i += NTHREADS) {
        int v = i >> 5, cI = i & 31;
        float s = 0.f;
#pragma unroll
        for (int qq = 0; qq < 8; ++qq) s += part[(qq * 9 + v) * 32 + cI];
        P_mod(p)[((long)l * 9 + v) * 6144 + n0 + cI] = s + p.b_ada[l * 6144 + n0 + cI];
      }
      __syncthreads();
    }
  }
  {
    const long n4 = 4194304L / 4;
    for (long i = (long)bid * NTHREADS + opaque_tid(); i < n4; i += (long)nb * NTHREADS) {
      f32x4 v = *(const f32x4*)(p.cache_k + i * 4);
      *(u32x2*)(P_ckb(p) + i * 4) = pack4(v);
    }
    for (int i = bid * NTHREADS + opaque_tid(); i < 2048; i += nb * NTHREADS) {
      int pos = i >> 5, f = i & 31;
      float inv = powf(10000.0f, -(float)f / 32.0f);
      float ang = (float)pos * inv;
      P_ropetab(p)[i] = cosf(ang);
      P_ropetab(p)[2048 + i] = sinf(ang);
    }
  }
}

__device__ __forceinline__ void phase_hm(const Params& p, int l, int g, int bid, int nb) {
  const int wid = opaque_tid() >> 6, lane = opaque_tid() & 63;
  const float* gw = p.n_pre_mix + l * 1024;
  for (int t = bid * 4 + wid; t < TG; t += nb * 4) {
    const int gt = gtok_of(g, t);
    const float* xrow = (l == 0) ? (gt < 8192 ? p.x_prompt + (long)gt * 1024 : p.x_sample + (long)(gt - 8192) * 1024)
                                 : p.out + (long)gt * 1024;
    const float* md = P_mod(p) + ((long)l * 9 + modidx_of(g, t)) * 6144;
    f32x4 v[4];
    float ss = 0.f;
#pragma unroll
    for (int i = 0; i < 4; ++i) {
      v[i] = *(const f32x4*)(xrow + i * 256 + lane * 4);
      ss += v[i][0] * v[i][0] + v[i][1] * v[i][1] + v[i][2] * v[i][2] + v[i][3] * v[i][3];
    }
    const float r = rsqrtf(wave_sum(ss) * (1.f / 1024.f) + EPSV);
#pragma unroll
    for (int i = 0; i < 4; ++i) {
      const int c = i * 256 + lane * 4;
      f32x4 gv = *(const f32x4*)(gw + c), sh = *(const f32x4*)(md + c), sc = *(const f32x4*)(md + 1024 + c), o;
#pragma unroll
      for (int q = 0; q < 4; ++q) o[q] = (v[i][q] * r * gv[q]) * (1.f + sc[q]) + sh[q];
      *(u32x2*)(P_hm(p) + (long)t * 1024 + c) = pack4(o);
    }
  }
}

__device__ __forceinline__ void phase_post_mix(const Params& p, int l, int g, int bid, int nb) {
  const int wid = opaque_tid() >> 6, lane = opaque_tid() & 63;
  const float* gpm = p.n_post_mix + l * 1024;
  const float* gpf = p.n_pre_ffn + l * 1024;
  for (int t = bid * 4 + wid; t < TG; t += nb * 4) {
    const int gt = gtok_of(g, t);
    const float* xrow = (l == 0) ? (gt < 8192 ? p.x_prompt + (long)gt * 1024 : p.x_sample + (long)(gt - 8192) * 1024)
                                 : p.out + (long)gt * 1024;
    const float* md = P_mod(p) + ((long)l * 9 + modidx_of(g, t)) * 6144;
    const u16* mrow = P_mixed(p) + (long)t * 1024;
    f32x4 mv[4], xv[4];
    float ss = 0.f;
#pragma unroll
    for (int i = 0; i < 4; ++i) {
      mv[i] = unpack4v(*(const u32x2*)(mrow + i * 256 + lane * 4));
      xv[i] = *(const f32x4*)(xrow + i * 256 + lane * 4);
      ss += mv[i][0] * mv[i][0] + mv[i][1] * mv[i][1] + mv[i][2] * mv[i][2] + mv[i][3] * mv[i][3];
    }
    const float r = rsqrtf(wave_sum(ss) * (1.f / 1024.f) + EPSV);
    float s2 = 0.f;
#pragma unroll
    for (int i = 0; i < 4; ++i) {
      const int c = i * 256 + lane * 4;
      f32x4 gv = *(const f32x4*)(gpm + c), g1 = *(const f32x4*)(md + 2048 + c);
#pragma unroll
      for (int q = 0; q < 4; ++q) {
        xv[i][q] = xv[i][q] + g1[q] * (mv[i][q] * r * gv[q]);
        s2 += xv[i][q] * xv[i][q];
      }
      *(u32x2*)((u16*)(p.out + (long)gt * 1024) + c) = pack4(xv[i]);
    }
    const float r2 = rsqrtf(wave_sum(s2) * (1.f / 1024.f) + EPSV);
#pragma unroll
    for (int i = 0; i < 4; ++i) {
      const int c = i * 256 + lane * 4;
      f32x4 gv = *(const f32x4*)(gpf + c), sh = *(const f32x4*)(md + 3072 + c), sc = *(const f32x4*)(md + 4096 + c), o;
#pragma unroll
      for (int q = 0; q < 4; ++q) o[q] = (xv[i][q] * r2 * gv[q]) * (1.f + sc[q]) + sh[q];
      *(u32x2*)(P_hm(p) + (long)t * 1024 + c) = pack4(o);
    }
  }
}

__device__ __forceinline__ void phase_post_ffn(const Params& p, int l, int g, int bid, int nb) {
  const int wid = opaque_tid() >> 6, lane = opaque_tid() & 63;
  const float* gpf = p.n_post_ffn + l * 1024;
  for (int t = bid * 4 + wid; t < TG; t += nb * 4) {
    const int gt = gtok_of(g, t);
    float* xrow = p.out + (long)gt * 1024;
    const float* md = P_mod(p) + ((long)l * 9 + modidx_of(g, t)) * 6144;
    const u16* mrow = P_mixed(p) + (long)t * 1024;
    f32x4 mv[4], xb[4];
    float ss = 0.f;
#pragma unroll
    for (int i = 0; i < 4; ++i) {
      mv[i] = unpack4v(*(const u32x2*)(mrow + i * 256 + lane * 4));
      xb[i] = unpack4v(*(const u32x2*)((const u16*)xrow + i * 256 + lane * 4));
      ss += mv[i][0] * mv[i][0] + mv[i][1] * mv[i][1] + mv[i][2] * mv[i][2] + mv[i][3] * mv[i][3];
    }
    const float r = rsqrtf(wave_sum(ss) * (1.f / 1024.f) + EPSV);
#pragma unroll
    for (int i = 0; i < 4; ++i) {
      const int c = i * 256 + lane * 4;
      f32x4 gv = *(const f32x4*)(gpf + c), g2 = *(const f32x4*)(md + 5120 + c), xv = xb[i];
#pragma unroll
      for (int q = 0; q < 4; ++q) xv[q] = xv[q] + g2[q] * (mv[i][q] * r * gv[q]);
      *(f32x4*)(xrow + c) = xv;
    }
  }
}

__device__ __forceinline__ void phase_proj(const Params& p, int l, int g, char* lds, int t_first, int t_end, int t_stride) {
  const int tid = opaque_tid(), wid = tid >> 6, lane = tid & 63, fr = lane & 15, fq = lane >> 4;
  const int wn = wid >> 1, wm = wid & 1;
  const int nc = g_ctx_nb(g) * 256;
  const int MT = TG / 256, NT = 4608 / 128;
  const u16* W = P_wt1(p) + l * WT1_SZ;
  const float kscale = 0.08838834764831845f, qscale = 0.125f;
  for (int tile = t_first; tile < t_end; tile += t_stride) {
    const int mt = tile % MT, ntl = tile / MT, m0 = mt * 256, n0 = ntl * 128;
    f32x4 acc[4][8];
    zero_acc8(acc);
    gemm_kloop8(acc, P_hm(p) + (long)m0 * 1024, 1024, W + (long)n0 * 1024, 1024, 1024, lds);
    const int nbk = n0 + wn * 64;
    const bool is_smp = m0 >= nc;
    if (nbk < 1024) {
      const int h8 = nbk >> 7, blk = (nbk >> 6) & 1, h = h8 & 3;
      const bool isk = h8 >= 4;
      const float lgf_ = log_sigmoid(p.decay_logit[(l * 2 + 0) * 4 + h]), lgb_ = log_sigmoid(p.decay_logit[(l * 2 + 1) * 4 + h]);
#pragma unroll
      for (int j = 0; j < 8; ++j) {
        const int tl = m0 + wm * 128 + j * 16 + fr;
        const int tc_ = tcol_of(tl);
        int pos = 0;
        if (is_smp) { int s = (tl - nc) & 2047; pos = blk == 0 ? (s >> 6) : (s & 63); }
#pragma unroll
        for (int i = 0; i < 2; ++i) {
          f32x4 v1 = acc[i][j], v2 = acc[i + 2][j], o1, o2;
          const int f0 = i * 16 + fq * 4;
          if (is_smp) {
            f32x4 cs = *(const f32x4*)(P_ropetab(p) + pos * 32 + f0), sn = *(const f32x4*)(P_ropetab(p) + 2048 + pos * 32 + f0);
#pragma unroll
            for (int q = 0; q < 4; ++q) { o1[q] = v1[q] * cs[q] - v2[q] * sn[q]; o2[q] = v1[q] * sn[q] + v2[q] * cs[q]; }
          } else { o1 = v1; o2 = v2; }
          const int d1 = blk * 32 + f0;
          if (!isk) {
            *(u32x2*)(P_rq(p) + (long)tl * 512 + h * 128 + d1) = pack4(o1);
            *(u32x2*)(P_rq(p) + (long)tl * 512 + h * 128 + d1 + 64) = pack4(o2);
          } else {
#pragma unroll
            for (int q = 0; q < 4; ++q) { o1[q] *= kscale; o2[q] *= kscale; }
            *(u32x2*)(P_rk(p) + (long)tl * 512 + h * 128 + d1) = pack4(o1);
            *(u32x2*)(P_rk(p) + (long)tl * 512 + h * 128 + d1 + 64) = pack4(o2);
            {
              const int pp = tl & 127;
              const float zf = __expf(lgf_ * (float)(127 - pp)), zb = __expf(lgb_ * (float)pp);
#pragma unroll
              for (int q = 0; q < 4; ++q) {
                P_kt(p)[(long)(h * 128 + d1 + q) * TG + tc_] = f2bf(o1[q] * zf);
                P_kt(p)[(long)(h * 128 + d1 + 64 + q) * TG + tc_] = f2bf(o2[q] * zf);
                P_ktb(p)[(long)(h * 128 + d1 + q) * TG + tc_] = f2bf(o1[q] * zb);
                P_ktb(p)[(long)(h * 128 + d1 + 64 + q) * TG + tc_] = f2bf(o2[q] * zb);
              }
            }
          }
        }
      }
    } else {
#pragma unroll
      for (int j = 0; j < 8; ++j) {
        const int tl = m0 + wm * 128 + j * 16 + fr;
#pragma unroll
        for (int i = 0; i < 4; ++i) {
          const int n = nbk + i * 16 + fq * 4;
          f32x4 v = acc[i][j];
          if (nbk < 2048) {
            const int e = n - 1024;
#pragma unroll
            for (int q = 0; q < 4; ++q) P_vt(p)[(long)(e + q) * TG + tcol_of(tl)] = f2bf(v[q]);
          } else if (nbk < 3072) {
            f32x4 o;
#pragma unroll
            for (int q = 0; q < 4; ++q) o[q] = siluf(v[q]);
            *(u32x2*)(P_rg(p) + (long)tl * 1024 + (n - 2048)) = pack4(o);
          } else if (nbk < 3584) {
            f32x4 o;
#pragma unroll
            for (int q = 0; q < 4; ++q) o[q] = v[q] * qscale;
            *(u32x2*)(P_nq(p) + (long)tl * 512 + (n - 3072)) = pack4(o);
          } else if (nbk < 4096) {
            *(u32x2*)(P_nk(p) + (long)tl * 512 + (n - 3584)) = pack4(v);
            if (!is_smp) {
              const int b = tl >> 8, s = tl & 255;
              *(f32x4*)(p.out + OUT_NK + (((long)b * 2 + l) * 256 + s) * 512 + (n - 3584)) = v;
            }
          } else {
            const int cI = n - 4096;
#pragma unroll
            for (int q = 0; q < 4; ++q) P_nvt(p)[(long)(cI + q) * TG + tcol_of(tl)] = f2bf(v[q]);
            if (!is_smp) {
              const int b = tl >> 8, s = tl & 255;
              *(f32x4*)(p.out + OUT_NV + (((long)b * 2 + l) * 256 + s) * 512 + cI) = v;
            }
          }
        }
      }
    }
  }
}

__device__ __forceinline__ long st_slot(int g, bool smp, int seq, int h, int dir, int c) {
  return smp ? (long)g_ctx_nb(g) * 16 + seq * 128 + (h * 2 + dir) * 16 + c : (long)seq * 16 + (h * 2 + dir) * 2 + c;
}

__device__ __forceinline__ void uchunk_unit(const Params& p, int l, int g, int unit, char* lds) {
  const int tid = opaque_tid(), wid = tid >> 6, lane = tid & 63, fr = lane & 15, fq = lane >> 4;
  const int wn = wid >> 1, wm = wid & 1;
  const int n_smp_units = g_smp_nb(g) * 128;
  const int nc = g_ctx_nb(g) * 256;
  if (unit < n_smp_units) {
    const int seq = unit >> 7, rem = unit & 127, h = rem >> 5, dir = (rem >> 4) & 1, c = rem & 15;
    const int tc = nc + seq * 2048 + c * 128;
    const u16* W = (dir == 0 ? P_kt(p) : P_ktb(p)) + (long)(h * 128) * TG + tc;
    const u16* X = P_vt(p) + (long)(h * 256) * TG + tc;
    f32x4 acc[4][8];
    zero_acc8(acc);
    gemm_kloop8(acc, X, TG, W, TG, 128, lds);
    u16* st = P_St(p) + st_slot(g, true, seq, h, dir, c) * 32768;
#pragma unroll
    for (int j = 0; j < 8; ++j) {
      const int e = wm * 128 + j * 16 + fr;
#pragma unroll
      for (int i = 0; i < 4; ++i) *(u32x2*)(st + (long)e * 128 + wn * 64 + i * 16 + fq * 4) = pack4(acc[i][j]);
    }
  } else {
    const int u2 = unit - n_smp_units, seq = u2 >> 3, rem = u2 & 7, h = rem >> 1, dir = rem & 1;
    const int c1 = dir == 0 ? 0 : 1, c2 = 1 - c1;
    const float gch = expf(log_sigmoid(p.decay_logit[(l * 2 + dir) * 4 + h]) * 128.f);
    const u16* Wb = (dir == 0 ? P_kt(p) : P_ktb(p)) + (long)(h * 128) * TG + seq * 256;
    const u16* Xb = P_vt(p) + (long)(h * 256) * TG + seq * 256;
    f32x4 acc[4][8];
    zero_acc8(acc);
    gemm_kloop8(acc, Xb + c1 * 128, TG, Wb + c1 * 128, TG, 128, lds);
    u16* st1 = P_St(p) + st_slot(g, false, seq, h, dir, c1) * 32768;
    u16* st2 = P_St(p) + st_slot(g, false, seq, h, dir, c2) * 32768;
#pragma unroll
    for (int j = 0; j < 8; ++j) {
      const int e = wm * 128 + j * 16 + fr;
#pragma unroll
      for (int i = 0; i < 4; ++i) {
        const long o = (long)e * 128 + wn * 64 + i * 16 + fq * 4;
        u32x2 z; z.x = 0u; z.y = 0u;
        *(u32x2*)(st1 + o) = z;
        *(u32x2*)(st2 + o) = pack4(acc[i][j]);
        acc[i][j] *= gch;
      }
    }
    gemm_kloop8(acc, Xb + c2 * 128, TG, Wb + c2 * 128, TG, 128, lds);
    float* so = p.out + OUT_ST + ((((long)seq * 2 + l) * 2 + dir) * 4 + h) * 32768;
#pragma unroll
    for (int j = 0; j < 8; ++j) {
      const int e = wm * 128 + j * 16 + fr;
#pragma unroll
      for (int i = 0; i < 4; ++i)
#pragma unroll
        for (int q = 0; q < 4; ++q) so[(long)(wn * 64 + i * 16 + fq * 4 + q) * 256 + e] = acc[i][j][q];
    }
  }
}

template <int NCH>
__device__ __forceinline__ void prefix_item(u16* base, long cstride, bool rev, float gch, f32x4& S) {
  u32x2 u[NCH];
#pragma unroll
  for (int s = 0; s < NCH; ++s) u[s] = *(const u32x2*)(base + (long)(rev ? NCH - 1 - s : s) * cstride);
#pragma unroll
  for (int s = 0; s < NCH; ++s) {
    *(u32x2*)(base + (long)(rev ? NCH - 1 - s : s) * cstride) = pack4(S);
    float uf[4];
    unpack4(u[s], uf);
#pragma unroll
    for (int q = 0; q < 4; ++q) S[q] = gch * S[q] + uf[q];
  }
}
__device__ __forceinline__ void phase_prefix(const Params& p, int l, int g, int bid, int nb) {
  const int tid = opaque_tid();
  const int n_ch = g_smp_nb(g) * 8;
  for (int it = bid * NTHREADS + tid; it < n_ch * 8192; it += nb * NTHREADS) {
    const int chain = it >> 13, idx = it & 8191, e = idx >> 5, dq = idx & 31;
    const int seq = chain >> 3, h = (chain >> 1) & 3, dir = chain & 1;
    const float gch = expf(log_sigmoid(p.decay_logit[(l * 2 + dir) * 4 + h]) * 128.f);
    u16* base = P_St(p) + st_slot(g, true, seq, h, dir, 0) * 32768 + (long)e * 128 + dq * 4;
    const int bglob = g_smp_b0(g) + seq;
    const float* s0 = p.state_ret + ((((long)bglob * 2 + l) * 2 + dir) * 4 + h) * 32768 + e;
    f32x4 S;
#pragma unroll
    for (int q = 0; q < 4; ++q) S[q] = s0[(long)(dq * 4 + q) * 256];
    prefix_item<16>(base, 32768, dir == 1, gch, S);
  }
}

struct AttnCtx {
  const u16 *nk, *nvt, *ck, *cv;
  const float* rpb;
  int h, seqtok0, row_start, r, smp, wq, cs, fr, fq;
};
#define AT_STG 18432
__device__ __forceinline__ void at_issue(const AttnCtx& c, int t, int tid, i32x4 (&R)[4]) {
  const bool local = !c.smp || t < 8;
  const u16 *kbase, *vbase; int ldv;
  if (local) {
    const int key0 = c.smp ? c.seqtok0 + (c.row_start + t) * 64 : c.seqtok0 + t * 64;
    kbase = c.nk + (long)key0 * 512 + c.h * 64;
    vbase = c.nvt + (long)(c.h * 64) * TG + key0; ldv = TG;
  } else {
    const int key0 = (t - 8) * 64;
    kbase = c.ck + (long)key0 * 512 + c.h * 64;
    vbase = c.cv + (long)(c.h * 64) * 512 + key0; ldv = 512;
  }
  const int row = (tid >> 3) & 31, ch = tid & 7;
  const unsigned koff = (unsigned)(row * 512 + ch * 8), voff = (unsigned)(row * ldv + ch * 8);
  R[0] = *(const i32x4*)(kbase + koff);
  R[1] = *(const i32x4*)(kbase + 32 * 512 + koff);
  R[2] = *(const i32x4*)(vbase + voff);
  R[3] = *(const i32x4*)(vbase + (long)32 * ldv + voff);
}
__device__ __forceinline__ void at_write(char* stage, int tid, const i32x4 (&R)[4]) {
  const int row = (tid >> 3) & 31, ch = tid & 7;
  char* d = stage + row * 144 + ch * 16;
  *(i32x4*)(d) = R[0];
  *(i32x4*)(d + 32 * 144) = R[1];
  *(i32x4*)(d + 9216) = R[2];
  *(i32x4*)(d + 9216 + 32 * 144) = R[3];
}
__device__ __forceinline__ void attn_compute(const AttnCtx& c, int t, const char* stage, const float* rtab,
                                             const bf16x8 (&qf)[2], f32x4 (&O)[4], float& mrun, float& lrun) {
  const char* kb = stage + c.fr * 144 + c.fq * 16;
  const char* vb = kb + 9216;
  f32x4 S[4];
#pragma unroll
  for (int sub = 0; sub < 4; ++sub) {
    S[sub] = f32x4{0.f, 0.f, 0.f, 0.f};
#pragma unroll
    for (int ks = 0; ks < 2; ++ks)
      S[sub] = __builtin_amdgcn_mfma_f32_16x16x32_bf16(*(const bf16x8*)(kb + sub * 16 * 144 + ks * 64), qf[ks], S[sub], 0, 0, 0);
  }
  if (c.smp && t < 8) {
    const int dr = c.row_start + t - c.r + 7;
    const float* rp = rtab + dr * 31;
#pragma unroll
    for (int sub = 0; sub < 4; ++sub)
#pragma unroll
      for (int q = 0; q < 4; ++q) {
        const int kc = sub * 16 + c.fq * 4 + q;
        const bool valid = kc >= c.cs && kc < c.cs + 16;
        const int bi = min(max(kc - c.wq + 15, 0), 30);
        S[sub][q] = valid ? S[sub][q] + rp[bi] : -1e30f;
      }
  }
  float mx = -1e30f;
#pragma unroll
  for (int sub = 0; sub < 4; ++sub)
#pragma unroll
    for (int q = 0; q < 4; ++q) mx = fmaxf(mx, S[sub][q]);
  { const int ln_ = c.fq * 16 + c.fr; mx = fmaxf(mx, shfl_xor_l(mx, 16, ln_)); mx = fmaxf(mx, shfl_xor_l(mx, 32, ln_)); }
  const float mnew = fmaxf(mrun, mx);
  const float alpha = __expf(mrun - mnew);
  mrun = mnew;
  float ps = 0.f;
#pragma unroll
  for (int sub = 0; sub < 4; ++sub)
#pragma unroll
    for (int q = 0; q < 4; ++q) { float e = __expf(S[sub][q] - mnew); S[sub][q] = e; ps += e; }
  lrun = lrun * alpha + ps;
#pragma unroll
  for (int d = 0; d < 4; ++d) O[d] *= alpha;
#pragma unroll
  for (int s = 0; s < 2; ++s) {
    i32x4 pc = {(int)pk2(S[2 * s][0], S[2 * s][1]), (int)pk2(S[2 * s][2], S[2 * s][3]),
                (int)pk2(S[2 * s + 1][0], S[2 * s + 1][1]), (int)pk2(S[2 * s + 1][2], S[2 * s + 1][3])};
    bf16x8 pf = __builtin_bit_cast(bf16x8, pc);
#pragma unroll
    for (int d = 0; d < 4; ++d)
      O[d] = __builtin_amdgcn_mfma_f32_16x16x32_bf16(*(const bf16x8*)(vb + d * 16 * 144 + s * 64), pf, O[d], 0, 0, 0);
  }
}

__device__ __forceinline__ void attn_unit(const Params& p, int l, int g, int unit, char* lds) {
  const int tid = opaque_tid(), w = tid >> 6, lane = tid & 63, fr = lane & 15, fq = lane >> 4;
  const int nc = g_ctx_nb(g) * 256;
  const int n_smp_units = g_smp_nb(g) * 256;
  AttnCtx c;
  int qtok0, ntile, bglob = 0;
  c.fr = fr; c.fq = fq; c.r = 0; c.row_start = 0;
  if (unit < n_smp_units) {
    c.smp = 1;
    const int sb = unit >> 8, rem = unit & 255;
    c.r = rem >> 3; c.h = rem & 7;
    c.seqtok0 = nc + sb * 2048;
    qtok0 = c.seqtok0 + c.r * 64;
    c.row_start = min(max(c.r - 4, 0), 24);
    ntile = 16;
    bglob = g_smp_b0(g) + sb;
  } else {
    c.smp = 0;
    const int u = unit - n_smp_units;
    const int b = u >> 5, rem = u & 31;
    c.h = rem >> 2;
    const int qt = rem & 3;
    c.seqtok0 = b * 256;
    qtok0 = c.seqtok0 + qt * 64;
    ntile = 4;
  }
  c.nk = P_nk(p); c.nvt = P_nvt(p);
  c.ck = P_ckb(p) + ((long)bglob * 2 + l) * 262144;
  c.cv = P_cvt(p) + ((long)bglob * 2 + l) * 262144;
  c.rpb = p.rpb + ((long)l * 8 + c.h) * 15 * 31;
  c.wq = w * 16 + fr;
  c.cs = min(max(c.wq - 8, 0), 48);
  const int qtok = qtok0 + w * 16 + fr;
  char* st0 = lds;
  char* st1 = lds + AT_STG;
  float* rtab = (float*)(lds + 2 * AT_STG);
  if (c.smp) for (int i = tid; i < 465; i += NTHREADS) rtab[i] = c.rpb[i];
  i32x4 R0[4], R1[4], R2[4], R3[4];
  at_issue(c, 0, tid, R0);
  bf16x8 qf[2];
#pragma unroll
  for (int ks = 0; ks < 2; ++ks) qf[ks] = *(const bf16x8*)(P_nq(p) + (long)qtok * 512 + c.h * 64 + ks * 32 + fq * 8);
  at_write(st0, tid, R0);
  at_issue(c, 1, tid, R1);
  at_issue(c, 2, tid, R2);
  at_issue(c, 3, tid, R3);
  if (ntile > 4) at_issue(c, 4, tid, R0);
  f32x4 O[4];
#pragma unroll
  for (int d = 0; d < 4; ++d) O[d] = f32x4{0.f, 0.f, 0.f, 0.f};
  float mrun = -1e30f, lrun = 0.f;
  __syncthreads();
  for (int t = 0; t < ntile; t += 4) {
    at_write(st1, tid, R1);
    if (t + 5 < ntile) at_issue(c, t + 5, tid, R1);
    attn_compute(c, t, st0, rtab, qf, O, mrun, lrun);
    __syncthreads();
    at_write(st0, tid, R2);
    if (t + 6 < ntile) at_issue(c, t + 6, tid, R2);
    attn_compute(c, t + 1, st1, rtab, qf, O, mrun, lrun);
    __syncthreads();
    at_write(st1, tid, R3);
    if (t + 7 < ntile) at_issue(c, t + 7, tid, R3);
    attn_compute(c, t + 2, st0, rtab, qf, O, mrun, lrun);
    __syncthreads();
    if (t + 4 < ntile) at_write(st0, tid, R0);
    if (t + 8 < ntile) at_issue(c, t + 8, tid, R0);
    attn_compute(c, t + 3, st1, rtab, qf, O, mrun, lrun);
    __syncthreads();
  }
  lrun += shfl_xor_l(lrun, 16, lane);
  lrun += shfl_xor_l(lrun, 32, lane);
  const float inv = 1.f / lrun;
#pragma unroll
  for (int d = 0; d < 4; ++d) {
    f32x4 o = O[d] * inv;
    *(u32x2*)(P_yna(p) + (long)qtok * 512 + c.h * 64 + d * 16 + fq * 4) = pack4(o);
  }
}

#define MIXA_QUEUE(q_, n_, CALL_)                                              \
  {                                                                             \
    int nxt = 0;                                                                \
    if (t0) nxt = (int)atomicAdd(&ctr[q_], 1u);                                 \
    for (;;) {                                                                  \
      if (t0) *snext = nxt;                                                     \
      __syncthreads();                                                          \
      const int u = __builtin_amdgcn_readfirstlane(*snext);                     \
      __syncthreads();                                                          \
      if (u >= (n_)) break;                                                     \
      if (t0) nxt = (int)atomicAdd(&ctr[q_], 1u);                               \
      CALL_;                                                                    \
    }                                                                           \
  }
__device__ __forceinline__ void phase_mix_a(const Params& p, int l, int g, char* lds, unsigned* ctr, bool upper) {
  const int n_rq = 4 * (TG / 256);
  const int n_scan = g_smp_nb(g) * 128 + g_ctx_nb(g) * 8;
  const int n_attn = g_smp_nb(g) * 256 + g_ctx_nb(g) * 32;
  volatile int* snext = (volatile int*)(lds + 65520);
  const bool t0 = opaque_tid() == 0;
  if (upper) MIXA_QUEUE(2, n_attn, attn_unit(p, l, g, u, lds))
  MIXA_QUEUE(0, n_rq, phase_proj(p, l, g, lds, u, u + 1, 1))
  MIXA_QUEUE(1, n_scan, uchunk_unit(p, l, g, u, lds))
  if (!upper) MIXA_QUEUE(2, n_attn, attn_unit(p, l, g, u, lds))
}

__device__ __forceinline__ void retout_unit(const Params& p, int l, int g, int unit, char* lds) {
  const int tid = opaque_tid(), w = tid >> 6, lane = tid & 63, fr = lane & 15, fq = lane >> 4;
  const int nc = g_ctx_nb(g) * 256;
  const int n_smp_units = g_smp_nb(g) * 128;
  bool smp;
  int seq, h, c, half;
  if (unit < n_smp_units) { smp = true; const int hn = n_smp_units >> 1; half = unit >= hn; const int idx = unit - half * hn; seq = idx >> 6; h = (idx >> 4) & 3; c = idx & 15; }
  else { smp = false; const int nctx = g_ctx_nb(g) * 16, hn = nctx >> 1; const int u = unit - n_smp_units; half = u >= hn; const int idx = u - half * hn; seq = idx >> 3; h = (idx >> 1) & 3; c = idx & 1; }
  const int tok0 = smp ? nc + seq * 2048 : seq * 256;
  const int tc = tok0 + c * 128;
  const float lgf = log_sigmoid(p.decay_logit[(l * 2 + 0) * 4 + h]);
  const float lgb = log_sigmoid(p.decay_logit[(l * 2 + 1) * 4 + h]);
  char* bfr = lds;
  float* red = (float*)(lds + 49152);
  {
    const int pn = half * 64 + w * 16 + fr;
    const int qtok = tc + pn;
    bf16x8 qf[4];
#pragma unroll
    for (int ks = 0; ks < 4; ++ks) qf[ks] = *(const bf16x8*)(P_rq(p) + (long)qtok * 512 + h * 128 + ks * 32 + fq * 8);
#pragma unroll
    for (int s = 0; s < 4; ++s) {
      f32x4 sc[2];
#pragma unroll
      for (int k2 = 0; k2 < 2; ++k2) {
        const int ktile = 2 * s + k2;
        sc[k2] = f32x4{0.f, 0.f, 0.f, 0.f};
#pragma unroll
        for (int ks = 0; ks < 4; ++ks) {
          bf16x8 kf = *(const bf16x8*)(P_rk(p) + (long)(tc + ktile * 16 + fr) * 512 + h * 128 + ks * 32 + fq * 8);
          sc[k2] = __builtin_amdgcn_mfma_f32_16x16x32_bf16(kf, qf[ks], sc[k2], 0, 0, 0);
        }
#pragma unroll
        for (int q = 0; q < 4; ++q) {
          const int pm = ktile * 16 + fq * 4 + q;
          const int diff = pn - pm;
          float dcy = diff > 0 ? __expf(lgf * (float)diff) : (diff < 0 ? __expf(lgb * (float)(-diff)) : 2.0f);
          sc[k2][q] *= dcy;
        }
      }
      i32x4 pc = {(int)pk2(sc[0][0], sc[0][1]), (int)pk2(sc[0][2], sc[0][3]), (int)pk2(sc[1][0], sc[1][1]), (int)pk2(sc[1][2], sc[1][3])};
      *(i32x4*)(bfr + ((w * 12 + s) * 64 + lane) * 16) = pc;
    }
    const float xif = __expf(lgf * (float)(pn + 1)), xib = __expf(lgb * (float)(128 - pn));
#pragma unroll
    for (int ks = 0; ks < 4; ++ks) {
      float qv[8];
#pragma unroll
      for (int e8 = 0; e8 < 8; ++e8) qv[e8] = bf2f((u16)qf[ks][e8]);
      i32x4 xf = {(int)pk2(qv[0] * xif, qv[1] * xif), (int)pk2(qv[2] * xif, qv[3] * xif), (int)pk2(qv[4] * xif, qv[5] * xif), (int)pk2(qv[6] * xif, qv[7] * xif)};
      i32x4 xb = {(int)pk2(qv[0] * xib, qv[1] * xib), (int)pk2(qv[2] * xib, qv[3] * xib), (int)pk2(qv[4] * xib, qv[5] * xib), (int)pk2(qv[6] * xib, qv[7] * xib)};
      *(i32x4*)(bfr + ((w * 12 + 4 + ks) * 64 + lane) * 16) = xf;
      *(i32x4*)(bfr + ((w * 12 + 8 + ks) * 64 + lane) * 16) = xb;
    }
  }
  __syncthreads();
  const u16* stf = P_St(p) + st_slot(g, smp, seq, h, 0, c) * 32768;
  const u16* stb = P_St(p) + st_slot(g, smp, seq, h, 1, c) * 32768;
  f32x4 acc[4][4];
#pragma unroll
  for (int es = 0; es < 4; ++es) {
    const int erow = (w * 4 + es) * 16 + fr;
    const u16* vrow = P_vt(p) + (long)(h * 256 + erow) * TG + tc + fq * 8;
    const u16* sfr = stf + (long)erow * 128 + fq * 8;
    const u16* sbr = stb + (long)erow * 128 + fq * 8;
    bf16x8 af[12];
#pragma unroll
    for (int k = 0; k < 4; ++k) { af[k] = *(const bf16x8*)(vrow + k * 32); af[4 + k] = *(const bf16x8*)(sfr + k * 32); af[8 + k] = *(const bf16x8*)(sbr + k * 32); }
#pragma unroll
    for (int qs = 0; qs < 4; ++qs) {
      f32x4 a = f32x4{0.f, 0.f, 0.f, 0.f};
#pragma unroll
      for (int k = 0; k < 12; ++k)
        a = __builtin_amdgcn_mfma_f32_16x16x32_bf16(af[k], *(const bf16x8*)(bfr + ((qs * 12 + k) * 64 + lane) * 16), a, 0, 0, 0);
      acc[es][qs] = a;
    }
    __builtin_amdgcn_sched_barrier(0);
  }
#pragma unroll
  for (int qs = 0; qs < 4; ++qs) {
    float s1 = 0.f, s2 = 0.f;
#pragma unroll
    for (int es = 0; es < 4; ++es)
#pragma unroll
      for (int q = 0; q < 4; ++q) { const float v = acc[es][qs][q]; s1 += v; s2 += v * v; }
    s1 += shfl_xor_l(s1, 16, lane); s1 += shfl_xor_l(s1, 32, lane);
    s2 += shfl_xor_l(s2, 16, lane); s2 += shfl_xor_l(s2, 32, lane);
    if (fq == 0) { red[(w * 64 + qs * 16 + fr) * 2] = s1; red[(w * 64 + qs * 16 + fr) * 2 + 1] = s2; }
  }
  __syncthreads();
  const float* gn = p.gn_gain + l * 1024 + h * 256;
#pragma unroll
  for (int qs = 0; qs < 4; ++qs) {
    float s1 = 0.f, s2 = 0.f;
#pragma unroll
    for (int ww = 0; ww < 4; ++ww) { s1 += red[(ww * 64 + qs * 16 + fr) * 2]; s2 += red[(ww * 64 + qs * 16 + fr) * 2 + 1]; }
    const float mu = s1 * (1.f / 256.f);
    const float var = fmaxf(s2 * (1.f / 256.f) - mu * mu, 0.f);
    const float rstd = rsqrtf(var + EPSV);
    const int qtok = tc + half * 64 + qs * 16 + fr;
#pragma unroll
    for (int es = 0; es < 4; ++es) {
      const int e = (w * 4 + es) * 16 + fq * 4;
      f32x4 gv = *(const f32x4*)(gn + e);
      u32x2 gr = *(const u32x2*)(P_rg(p) + (long)qtok * 1024 + h * 256 + e);
      float gf[4];
      unpack4(gr, gf);
      f32x4 o;
#pragma unroll
      for (int q = 0; q < 4; ++q) o[q] = (acc[es][qs][q] - mu) * rstd * gv[q] * gf[q];
      *(u32x2*)(P_yret(p) + (long)qtok * 1024 + h * 256 + e) = pack4(o);
    }
  }
  __syncthreads();
}

__device__ __forceinline__ void phase_retout(const Params& p, int l, int g, char* lds, int bid, int nb) {
  const int n = g_smp_nb(g) * 128 + g_ctx_nb(g) * 16;
  for (int u = bid; u < n; u += nb) retout_unit(p, l, g, u, lds);
}

__device__ __forceinline__ void phase_gate(const Params& p, int l, char* lds, int bid, int nb) {
  const int tid = opaque_tid(), wid = tid >> 6, lane = tid & 63, fr = lane & 15, fq = lane >> 4;
  const int wn = wid >> 1, wm = wid & 1;
  const int MT = TG / 256, NT = 16;
  for (int tile = bid; tile < MT * NT; tile += nb) {
    const int mt = tile % MT, ntl = tile / MT, m0 = mt * 256, n0 = ntl * 128;
    f32x4 acc[4][8];
    zero_acc8(acc);
    gemm_kloop8(acc, P_hm(p) + (long)m0 * 1024, 1024, P_wt_g(p) + l * WTG_SZ + (long)n0 * 1024, 1024, 1024, lds);
#pragma unroll
    for (int j = 0; j < 8; ++j) {
      const int tl = m0 + wm * 128 + j * 16 + fr;
#pragma unroll
      for (int i = 0; i < 4; ++i) {
        const int n = n0 + wn * 64 + i * 16 + fq * 4;
        f32x4 s;
#pragma unroll
        for (int q = 0; q < 4; ++q) s[q] = sigmf(acc[i][j][q]);
        *(u32x2*)(P_gbuf(p) + (long)tl * 2048 + n) = pack4(s);
      }
    }
  }
}

__device__ __forceinline__ void phase_mixout(const Params& p, int l, int g, char* lds, int bid, int nb) {
  constexpr int NJ = 6;
  const int tid = opaque_tid(), wid = tid >> 6, lane = tid & 63, fr = lane & 15, fq = lane >> 4;
  const int wn = wid >> 1, wm = wid & 1;
  const int MT = TG / (NJ * 32), NT = 8;
  for (int tile = bid; tile < MT * NT; tile += nb) {
    const int mt = tile % MT, ntl = tile / MT, m0 = mt * (NJ * 32), n0 = ntl * 128;
    f32x4 acc[4][NJ];
    zero_accN<NJ>(acc);
    gemm_kloopN<NJ>(acc, P_yret(p) + (long)m0 * 1024, 1024, P_wt_ret(p) + l * WTR_SZ + (long)n0 * 1024, 1024, 1024, lds);
#pragma unroll
    for (int j = 0; j < NJ; ++j) {
      const int tl = m0 + wm * (NJ * 16) + j * 16 + fr;
#pragma unroll
      for (int i = 0; i < 4; ++i) {
        const int n = n0 + wn * 64 + i * 16 + fq * 4;
        float a[4], b[4];
        unpack4(*(const u32x2*)(P_gbuf(p) + (long)tl * 2048 + n), a);
        unpack4(*(const u32x2*)(P_gbuf(p) + (long)tl * 2048 + 1024 + n), b);
#pragma unroll
        for (int q = 0; q < 4; ++q) acc[i][j][q] = acc[i][j][q] * a[q] / b[q];
      }
      __builtin_amdgcn_sched_barrier(0);
    }
    gemm_kloopN<NJ>(acc, P_yna(p) + (long)m0 * 512, 512, P_wt_na(p) + l * WTN_SZ + (long)n0 * 512, 512, 512, lds);
#pragma unroll
    for (int j = 0; j < NJ; ++j) {
      const int tl = m0 + wm * (NJ * 16) + j * 16 + fr;
#pragma unroll
      for (int i = 0; i < 4; ++i) {
        const int n = n0 + wn * 64 + i * 16 + fq * 4;
        float b[4];
        unpack4(*(const u32x2*)(P_gbuf(p) + (long)tl * 2048 + 1024 + n), b);
        f32x4 o;
#pragma unroll
        for (int q = 0; q < 4; ++q) o[q] = acc[i][j][q] * b[q];
        *(u32x2*)(P_mbuf(p) + (long)tl * 1024 + n) = pack4(o);
      }
      __builtin_amdgcn_sched_barrier(0);
    }
  }
}

__device__ __forceinline__ void phase_gemm_f32(const u16* X, int K, const u16* W, u16* out, char* lds, int bid, int nb) {
  constexpr int NJ = 6;
  const int tid = opaque_tid(), wid = tid >> 6, lane = tid & 63, fr = lane & 15, fq = lane >> 4;
  const int wn = wid >> 1, wm = wid & 1;
  const int MT = TG / (NJ * 32), NT = 8;
  for (int tile = bid; tile < MT * NT; tile += nb) {
    const int mt = tile % MT, ntl = tile / MT, m0 = mt * (NJ * 32), n0 = ntl * 128;
    f32x4 acc[4][NJ];
    zero_accN<NJ>(acc);
    gemm_kloopN<NJ>(acc, X + (long)m0 * K, K, W + (long)n0 * K, K, K, lds);
#pragma unroll
    for (int j = 0; j < NJ; ++j) {
      const int tl = m0 + wm * (NJ * 16) + j * 16 + fr;
#pragma unroll
      for (int i = 0; i < 4; ++i) {
        const int n = n0 + wn * 64 + i * 16 + fq * 4;
        *(u32x2*)(out + (long)tl * 1024 + n) = pack4(acc[i][j]);
      }
    }
  }
}

__device__ __forceinline__ void phase_ffn_up(const Params& p, int l, char* lds, int bid, int nb) {
  const int tid = opaque_tid(), wid = tid >> 6, lane = tid & 63, fr = lane & 15, fq = lane >> 4;
  const int wn = wid >> 1, wm = wid & 1;
  constexpr int NJ = 6;
  const int MT = TG / (NJ * 32), NT = 5632 / 128;
  const u16* W = P_wt_gu(p) + l * WTGU_SZ;
  for (int tile = bid; tile < MT * NT; tile += nb) {
    const int mt = tile % MT, ntl = tile / MT, m0 = mt * (NJ * 32), n0 = ntl * 128;
    f32x4 acc[4][NJ];
    zero_accN<NJ>(acc);
    gemm_kloopN<NJ>(acc, P_hm(p) + (long)m0 * 1024, 1024, W + (long)n0 * 1024, 1024, 1024, lds);
    const int ffb = ((n0 + wn * 64) >> 6) * 32;
#pragma unroll
    for (int j = 0; j < NJ; ++j) {
      const int tl = m0 + wm * (NJ * 16) + j * 16 + fr;
#pragma unroll
      for (int i = 0; i < 2; ++i) {
        f32x4 o;
#pragma unroll
        for (int q = 0; q < 4; ++q) o[q] = siluf(acc[i][j][q]) * acc[i + 2][j][q];
        *(u32x2*)(P_ubuf(p) + (long)tl * DFF + ffb + i * 16 + fq * 4) = pack4(o);
      }
    }
  }
}


#define XB_TMO      128
#define XB_XCNT(j)  (256  + 64 * (j))
#define XB_XSUB(j)  (1280 + 64 * (j))
#define XB_XGEN(j)  (2304 + 64 * (j))
#define XB_TOP      3328
#define XB_TOPGEN   3392
#define XCD_BAR_WORDS 3456
#define XB_SPIN_CAP (1u << 22)
#define LAS __attribute__((address_space(3)))
__device__ __forceinline__ unsigned xb_ld(unsigned* p)              { return __hip_atomic_load(p, __ATOMIC_RELAXED, __HIP_MEMORY_SCOPE_AGENT); }
__device__ __forceinline__ unsigned xb_add(unsigned* p, unsigned v) { return __hip_atomic_fetch_add(p, v, __ATOMIC_RELAXED, __HIP_MEMORY_SCOPE_AGENT); }
__device__ __forceinline__ unsigned xb_xcc_id() { return (unsigned)__builtin_amdgcn_s_getreg((3 << 11) | 20) & 0xFu; }
#define XB_SPIN(cond, bar) do { unsigned _sp = 0; while (cond) { __builtin_amdgcn_s_sleep(1); \
    if ((++_sp & 255u) == 0u) { if (xb_ld(&(bar)[XB_TMO])) break; if (_sp > XB_SPIN_CAP) { atomicAdd(&(bar)[XB_TMO], 1u); break; } } } } while (0)
struct XcdBarrier { unsigned* bar; unsigned x; volatile LAS unsigned* st; };
__device__ __forceinline__ XcdBarrier xcd_barrier_post(unsigned* bar, volatile LAS unsigned* st) {
    XcdBarrier b; b.bar = bar; b.x = xb_xcc_id(); b.st = st;
    if (threadIdx.x == 0) (void)xb_add(&bar[XB_XCNT(b.x)], 1u);
    return b;
}
__device__ __forceinline__ void xcd_barrier_complete(unsigned* bar, unsigned x, unsigned& nloc, unsigned& nx) {
    const unsigned G = gridDim.x * gridDim.y * gridDim.z;
    unsigned sum, cnt, mine, sp = 0u;
    for (;;) {
        sum = 0u; cnt = 0u; mine = 0u;
#pragma unroll
        for (unsigned j = 0; j < 16; ++j) { const unsigned c = xb_ld(&bar[XB_XCNT(j)]); sum += c; cnt += (c > 0u) ? 1u : 0u; mine = (j == x) ? c : mine; }
        if (sum == G) break;
        __builtin_amdgcn_s_sleep(1);
        if ((++sp & 255u) == 0u) { if (xb_ld(&bar[XB_TMO])) break; if (sp > XB_SPIN_CAP) { atomicAdd(&bar[XB_TMO], 1u); break; } }
    }
    nloc = mine > 0u ? mine : 1u; nx = cnt > 0u ? cnt : 1u;
}
__device__ __forceinline__ void xcd_barrier(const XcdBarrier& b) {
    asm volatile("s_waitcnt vmcnt(0)" ::: "memory");
    __syncthreads();
    if (threadIdx.x == 0) {
        unsigned* bar = b.bar;
        __builtin_amdgcn_s_waitcnt(0);
        unsigned nloc = b.st[0], nx = b.st[1];
        if (nloc == 0u) { xcd_barrier_complete(bar, b.x, nloc, nx); b.st[0] = nloc; b.st[1] = nx; }
        const unsigned old = xb_add(&bar[XB_XSUB(b.x)], 1u);
        const unsigned gen = old / nloc;
        if (old + 1u == (gen + 1u) * nloc) {
            __builtin_amdgcn_fence(__ATOMIC_RELEASE, "agent");
            asm volatile("s_waitcnt vmcnt(0)" ::: "memory");
            const unsigned og = xb_add(&bar[XB_TOP], 1u);
            const unsigned tg = og / nx;
            if (og + 1u == (tg + 1u) * nx) xb_add(&bar[XB_TOPGEN], 1u);
            else XB_SPIN(xb_ld(&bar[XB_TOPGEN]) == tg, bar);
            __builtin_amdgcn_fence(__ATOMIC_ACQUIRE, "agent");
            xb_add(&bar[XB_XGEN(b.x)], 1u);
            asm volatile("s_waitcnt vmcnt(0)" ::: "memory");
        } else {
            XB_SPIN(xb_ld(&bar[XB_XGEN(b.x)]) == gen, bar);
            __builtin_amdgcn_fence(__ATOMIC_ACQUIRE, "agent");
            asm volatile("s_waitcnt vmcnt(0)" ::: "memory");
        }
    }
    __syncthreads();
}

__device__ __forceinline__ void run_step(const Params& pin, int s, char* lds, int bid, int nb) {
  Params p = pin;
  { size_t z_ = 0; asm volatile("" : "+s"(z_)); p.ws = pin.ws + z_; p.out = pin.out + z_; }
  if (s == 0) { for (int rep_ = 0; rep_ < ((DUPMASK & 0x200) ? 2 : 1); ++rep_) phase0(p, lds, bid, nb); return; }
  if (s == 1) { phase_hm(p, 0, 0, bid, nb); return; }
  const int idx = s - 2, lg = idx / 10, ph = idx % 10, l = lg / NG, g = lg % NG;
#define REP(bit) for (int rep_ = 0; rep_ < ((DUPMASK & (bit)) ? 2 : 1); ++rep_)
  switch (ph) {
    case 0: phase_proj(p, l, g, lds, 4 * (TG / 256) + bid, (TG / 256) * 36, nb); break;
    case 1: phase_mix_a(p, l, g, lds, P_bar(p) + XCD_BAR_WORDS + 4 * s, bid * 2 >= nb); break;
    case 2: phase_prefix(p, l, g, bid, nb); break;
    case 3: {
      const int n_ret = g_smp_nb(g) * 128 + g_ctx_nb(g) * 16;
      const int u0 = bid >= n_ret ? bid : bid + ((n_ret - bid + nb - 1) / nb) * nb;
      if (bid * 2 >= nb) phase_gate(p, l, lds, u0 - n_ret, nb);
      phase_retout(p, l, g, lds, bid, nb);
      if (bid * 2 < nb) phase_gate(p, l, lds, u0 - n_ret, nb);
    } break;
    case 4: REP(8) phase_mixout(p, l, g, lds, bid, nb); break;
    case 5: REP(16) phase_gemm_f32(P_mbuf(p), 1024, P_wt_o(p) + l * WTO_SZ, P_mixed(p), lds, bid, nb); break;
    case 6: phase_post_mix(p, l, g, bid, nb); break;
    case 7: REP(64) phase_ffn_up(p, l, lds, bid, nb); break;
    case 8: REP(128) phase_gemm_f32(P_ubuf(p), DFF, P_wt_dn(p) + l * WTD_SZ, P_mixed(p), lds, bid, nb); break;
    default: {
      phase_post_ffn(p, l, g, bid, nb);
      const int g2 = g + 1 < NG ? g + 1 : 0, l2 = g + 1 < NG ? l : l + 1;
      if (l2 < 2) phase_hm(p, l2, g2, bid, nb);
    } break;
  }
}
#define NSTEPS (2 + 2 * NG * 10)
__global__ void __launch_bounds__(NTHREADS, 2) mega(Params p) {
  __shared__ __attribute__((aligned(1024))) char lds[65536];
  __shared__ uint4 xb_words;
  cg::grid_group grid = cg::this_grid();
  const int bid = blockIdx.x, nb = gridDim.x;
  if (threadIdx.x == 0) xb_words = make_uint4(0u, 0u, 0u, 0u);
  __syncthreads();
  XcdBarrier xb = xcd_barrier_post(P_bar(p), (volatile LAS unsigned*)&xb_words);
#pragma nounroll
  for (int s = 0; s < NSTEPS; ++s) {
    run_step(p, s, lds, bid, nb);
    if (s + 1 < NSTEPS) {
      if (s == 0) grid.sync();
      else xcd_barrier(xb);
    }
  }
}

extern "C" void kernel_launch(void* const* d_in, const int* in_sizes, int n_in, void* d_out, int out_size, void* d_ws,
                              size_t ws_size, hipStream_t stream) {
  static int grid_blocks = 0;
  if (!grid_blocks) {
    int dev = 0, cus = 0, per_cu = 0;
    (void)hipGetDevice(&dev);
    (void)hipDeviceGetAttribute(&cus, hipDeviceAttributeMultiprocessorCount, dev);
    (void)hipOccupancyMaxActiveBlocksPerMultiprocessor(&per_cu, (const void*)mega, NTHREADS, 0);
    if (per_cu > 2) per_cu = 2;
    grid_blocks = cus * per_cu;
    if (grid_blocks <= 0) { fprintf(stderr, "occupancy query failed (cus %d per_cu %d)\n", cus, per_cu); grid_blocks = -1; }
  }
  if (grid_blocks < 0) return;
  Params p{};
  const float* const* in = (const float* const*)d_in;
  p.x_prompt = in[0]; p.x_sample = in[1]; p.cache_k = in[2]; p.cache_v = in[3]; p.state_ret = in[4]; p.c = in[5]; p.c_ctx = in[6];
  p.w_ada = in[7]; p.b_ada = in[8]; p.n_pre_mix = in[9]; p.n_post_mix = in[10]; p.n_pre_ffn = in[11]; p.n_post_ffn = in[12];
  p.w_in = in[13]; p.decay_logit = in[14]; p.gn_gain = in[15]; p.rpb = in[16]; p.w_ret_out = in[17]; p.w_na_out = in[18];
  p.w_gate = in[19]; p.w_o = in[20]; p.w_ffn_gate = in[21]; p.w_ffn_up = in[22]; p.w_ffn_down = in[23];
  p.out = (float*)d_out;
  p.ws = (char*)d_ws;
  if (WS_TOTAL > ws_size) { fprintf(stderr, "workspace too small: need %zu have %zu\n", (size_t)WS_TOTAL, ws_size); return; }
  if (hipMemsetAsync(p.ws + OFF_bar, 0, (XCD_BAR_WORDS + 256) * 4, stream) != hipSuccess) { fprintf(stderr, "memset failed\n"); return; }
  void* args[] = {&p};
  hipError_t e = hipLaunchCooperativeKernel((void*)mega, dim3(grid_blocks), dim3(NTHREADS), args, 0, stream);
  if (e != hipSuccess) fprintf(stderr, "cooperative launch failed: %s (grid %d)\n", hipGetErrorString(e), grid_blocks);
}
```
